# Optimizing an MI355X kernel written in HIP

```python
import math, functools
import jax, jax.numpy as jnp
from jax import lax
import numpy as np

D_MODEL = 1024
BATCH = 4
SEQ = 4096
DEPTH = 2

A_HEADS = 4
A_QK_DIM = 32
A_V_DIM = 2 * A_QK_DIM
B_HEADS = 4
B_HEAD_DIM = 64
C_HEADS = 4
C_HEAD_DIM = 128
CONV_K = 4
CHUNK = 64
Q_BLOCK = 128
D_FF = 2816
A_WIDTH = A_HEADS * A_V_DIM
B_WIDTH = B_HEADS * B_HEAD_DIM
C_WIDTH = C_HEADS * C_HEAD_DIM
MIX_WIDTH = A_WIDTH + B_WIDTH + C_WIDTH
SPLIT_SIZES = (A_HEADS * 2 * A_QK_DIM, A_HEADS * 2 * A_QK_DIM, A_WIDTH, B_WIDTH, B_WIDTH, B_WIDTH, 3 * C_WIDTH, C_WIDTH, C_HEADS, C_HEADS)
N_IN = sum(SPLIT_SIZES)
DEEPNORM_ALPHA = (2.0 * DEPTH) ** 0.25
DEEPNORM_BETA = (8.0 * DEPTH) ** -0.25
LN_EPS = 1e-5
RMS_EPS = 1e-6

kernel_name = 'hybrid_diff_stick_deltanet_macaron'


def layer_norm(x, g, b):
    xf = x.astype(jnp.float32)
    mu = jnp.mean(xf, axis=-1, keepdims=True)
    var = jnp.mean(jnp.square(xf - mu), axis=-1, keepdims=True)
    return ((xf - mu) * lax.rsqrt(var + LN_EPS) * g.astype(jnp.float32) + b.astype(jnp.float32)).astype(x.dtype)


def rms_norm(x, g):
    xf = x.astype(jnp.float32)
    y = xf * lax.rsqrt(jnp.mean(jnp.square(xf), axis=-1, keepdims=True) + RMS_EPS)
    return (y * g.astype(jnp.float32)).astype(x.dtype)


def l2_normalize(x):
    xf = x.astype(jnp.float32)
    return xf * lax.rsqrt(jnp.sum(jnp.square(xf), axis=-1, keepdims=True) + RMS_EPS)


def swiglu(x, w_gu, w_down):
    gate, up = jnp.split(x @ w_gu, 2, axis=-1)
    return (jax.nn.silu(gate) * up) @ w_down


def sweep_query_blocks(block_fn, q):
    b, h, s, d = q.shape
    nb = s // Q_BLOCK
    q_blocks = jnp.moveaxis(q.reshape(b, h, nb, Q_BLOCK, d), 2, 0)
    starts = jnp.arange(nb, dtype=jnp.int32) * Q_BLOCK
    out = lax.map(lambda qs: block_fn(qs[0], qs[1]), (q_blocks, starts))
    return jnp.moveaxis(out, 0, 2).reshape(b, h, s, out.shape[-1])


def diff_attention_block(q_blk, start, k1, k2, v, lam):
    q1, q2 = jnp.split(q_blk, 2, axis=-1)
    t = start + jnp.arange(Q_BLOCK)
    s = jnp.arange(k1.shape[2])
    causal = s[None, :] <= t[:, None]
    scale = A_QK_DIM ** -0.5

    def probs(qi, ki):
        sc = jnp.einsum('bhqd,bhkd->bhqk', qi, ki).astype(jnp.float32) * scale
        return jax.nn.softmax(jnp.where(causal, sc, -jnp.inf), axis=-1)

    w = probs(q1, k1) - lam * probs(q2, k2)
    return jnp.einsum('bhqk,bhkd->bhqd', w.astype(v.dtype), v)


def stick_breaking_block(q_blk, start, k, v):
    t = start + jnp.arange(Q_BLOCK)
    s = jnp.arange(k.shape[2])
    strict = s[None, :] < t[:, None]
    z = jnp.einsum('bhqd,bhkd->bhqk', q_blk, k).astype(jnp.float32) * (B_HEAD_DIM ** -0.5)
    log_stay = jnp.where(strict, jax.nn.log_sigmoid(-z), 0.0)
    log_tail = lax.cumsum(log_stay, axis=3, reverse=True) - log_stay
    w = jnp.where(strict, jnp.exp(jax.nn.log_sigmoid(z) + log_tail), 0.0)
    return jnp.einsum('bhqk,bhkd->bhqd', w.astype(v.dtype), v)


def causal_depthwise_conv(x, w):
    return lax.conv_general_dilated(x, w[:, None, :].astype(x.dtype), window_strides=(1,), padding=[(w.shape[0] - 1, 0)], dimension_numbers=('NWC', 'WIO', 'NWC'), feature_group_count=x.shape[-1])


def gated_delta_rule(q, k, v, g, beta):
    b, h, s, dk = q.shape
    dv = v.shape[-1]
    n = s // CHUNK
    q = q.astype(jnp.float32) * (dk ** -0.5)
    k = k.astype(jnp.float32)
    v = v.astype(jnp.float32)
    chunks = lambda a: a.reshape(b, h, n, CHUNK, *a.shape[3:])
    q, k, v, g, beta = chunks(q), chunks(k), chunks(v), chunks(g), chunks(beta)
    g = jnp.cumsum(g, axis=-1)
    lower = jnp.tril(jnp.ones((CHUNK, CHUNK), dtype=bool))
    strict = jnp.tril(jnp.ones((CHUNK, CHUNK), dtype=bool), -1)
    gdiff = g[..., :, None] - g[..., None, :]
    decay = jnp.where(lower, jnp.exp(jnp.where(lower, gdiff, 0.0)), 0.0)
    k_beta = k * beta[..., None]
    l_mat = jnp.where(strict, jnp.einsum('bhncd,bhned->bhnce', k_beta, k) * decay, 0.0)
    t_mat = l_mat + jnp.eye(CHUNK, dtype=jnp.float32)
    rhs = jnp.concatenate([v * beta[..., None], k_beta * jnp.exp(g)[..., None]], axis=-1)
    sol = lax.linalg.triangular_solve(t_mat, rhs, left_side=True, lower=True, unit_diagonal=True)
    u, w = sol[..., :dv], sol[..., dv:]
    intra = jnp.where(lower, jnp.einsum('bhncd,bhned->bhnce', q, k) * decay, 0.0)

    def step(state, inp):
        q_i, k_i, u_i, w_i, g_i, a_i = inp
        v_new = u_i - jnp.einsum('bhck,bhkv->bhcv', w_i, state)
        out = jnp.einsum('bhck,bhkv->bhcv', q_i * jnp.exp(g_i)[..., None], state) + jnp.einsum('bhcs,bhsv->bhcv', a_i, v_new)
        g_last = g_i[..., -1:]
        state = state * jnp.exp(g_last)[..., None] + jnp.einsum('bhck,bhcv->bhkv', k_i * jnp.exp(g_last - g_i)[..., None], v_new)
        return state, out

    xs = tuple(jnp.moveaxis(a, 2, 0) for a in (q, k, u, w, g, intra))
    state0 = jnp.zeros((b, h, dk, dv), jnp.float32)
    _, out = lax.scan(step, state0, xs)
    return jnp.moveaxis(out, 0, 2).reshape(b, h, s, dv)


def hybrid_mixer(xn, w_in, conv_w, dn_a_log, dn_dt_bias, dn_norm_g, diff_lambda, diff_norm_g, sb_norm_g, w_out, lambda_init):
    b, s, _ = xn.shape
    points = np.cumsum(SPLIT_SIZES)[:-1].tolist()
    qa, ka, va, qb, kb, vb, qkv_c, z_c, beta_c, a_c = jnp.split(xn @ w_in, points, axis=-1)
    heads = lambda t, nh: t.reshape(b, s, nh, -1).transpose(0, 2, 1, 3)
    tokens = lambda t: t.transpose(0, 2, 1, 3).reshape(b, s, -1)

    k1, k2 = jnp.split(heads(ka, A_HEADS), 2, axis=-1)
    lf = diff_lambda.astype(jnp.float32)
    lam = jnp.exp(jnp.sum(lf[0] * lf[1])) - jnp.exp(jnp.sum(lf[2] * lf[3])) + lambda_init
    oa = sweep_query_blocks(functools.partial(diff_attention_block, k1=k1, k2=k2, v=heads(va, A_HEADS), lam=lam), heads(qa, A_HEADS))
    oa = rms_norm(oa, diff_norm_g) * (1.0 - lambda_init)

    ob = sweep_query_blocks(functools.partial(stick_breaking_block, k=heads(kb, B_HEADS), v=heads(vb, B_HEADS)), heads(qb, B_HEADS))
    ob = rms_norm(ob, sb_norm_g)

    qc, kc, vc = jnp.split(jax.nn.silu(causal_depthwise_conv(qkv_c, conv_w)), 3, axis=-1)
    g = -jnp.exp(dn_a_log.astype(jnp.float32)) * jax.nn.softplus(a_c.astype(jnp.float32) + dn_dt_bias.astype(jnp.float32))
    beta = jax.nn.sigmoid(beta_c.astype(jnp.float32))
    oc = gated_delta_rule(l2_normalize(heads(qc, C_HEADS)), l2_normalize(heads(kc, C_HEADS)), heads(vc, C_HEADS), g.transpose(0, 2, 1), beta.transpose(0, 2, 1))
    oc = rms_norm(oc, dn_norm_g) * jax.nn.silu(heads(z_c, C_HEADS).astype(jnp.float32))

    o = jnp.concatenate([tokens(oa).astype(xn.dtype), tokens(ob).astype(xn.dtype), tokens(oc).astype(xn.dtype)], axis=-1)
    return o @ w_out


def setup_inputs(seed: int = 0) -> dict:
    key = jax.random.key(seed)
    ks = jax.random.split(key, 16)
    f32 = jnp.float32
    x = jax.random.normal(ks[0], (BATCH, SEQ, D_MODEL), f32)
    ffn1_w_gu = jax.random.normal(ks[1], (DEPTH, D_MODEL, 2 * D_FF), f32) * D_MODEL ** -0.5
    ffn1_w_down = jax.random.normal(ks[2], (DEPTH, D_FF, D_MODEL), f32) * (D_FF ** -0.5 * DEEPNORM_BETA)
    ffn2_w_gu = jax.random.normal(ks[3], (DEPTH, D_MODEL, 2 * D_FF), f32) * D_MODEL ** -0.5
    ffn2_w_down = jax.random.normal(ks[4], (DEPTH, D_FF, D_MODEL), f32) * (D_FF ** -0.5 * DEEPNORM_BETA)
    ln_g = 1.0 + 0.02 * jax.random.normal(ks[5], (DEPTH, 3, D_MODEL), f32)
    ln_b = 0.02 * jax.random.normal(ks[6], (DEPTH, 3, D_MODEL), f32)
    w_in = jax.random.normal(ks[7], (DEPTH, D_MODEL, N_IN), f32) * D_MODEL ** -0.5
    conv_w = jax.random.normal(ks[8], (DEPTH, CONV_K, 3 * C_WIDTH), f32) * CONV_K ** -0.5
    dn_a_log = jnp.log(jax.random.uniform(ks[9], (DEPTH, C_HEADS), f32, 1.0, 16.0))
    dt = jnp.exp(jax.random.uniform(ks[10], (DEPTH, C_HEADS), f32, math.log(1e-3), math.log(1e-1)))
    dn_dt_bias = dt + jnp.log(-jnp.expm1(-dt))
    dn_norm_g = 1.0 + 0.02 * jax.random.normal(ks[11], (DEPTH, C_HEAD_DIM), f32)
    diff_lambda = 0.1 * jax.random.normal(ks[12], (DEPTH, 4, A_QK_DIM), f32)
    diff_norm_g = 1.0 + 0.02 * jax.random.normal(ks[13], (DEPTH, A_V_DIM), f32)
    sb_norm_g = 1.0 + 0.02 * jax.random.normal(ks[14], (DEPTH, B_HEAD_DIM), f32)
    w_out = jax.random.normal(ks[15], (DEPTH, MIX_WIDTH, D_MODEL), f32) * (MIX_WIDTH ** -0.5 * DEEPNORM_BETA)
    return {'x': x, 'ffn1_w_gu': ffn1_w_gu, 'ffn1_w_down': ffn1_w_down, 'ffn2_w_gu': ffn2_w_gu, 'ffn2_w_down': ffn2_w_down, 'ln_g': ln_g, 'ln_b': ln_b, 'w_in': w_in, 'conv_w': conv_w, 'dn_a_log': dn_a_log, 'dn_dt_bias': dn_dt_bias, 'dn_norm_g': dn_norm_g, 'diff_lambda': diff_lambda, 'diff_norm_g': diff_norm_g, 'sb_norm_g': sb_norm_g, 'w_out': w_out}


def reference(x, ffn1_w_gu, ffn1_w_down, ffn2_w_gu, ffn2_w_down, ln_g, ln_b, w_in, conv_w, dn_a_log, dn_dt_bias, dn_norm_g, diff_lambda, diff_norm_g, sb_norm_g, w_out):
    for l in range(DEPTH):
        lambda_init = 0.8 - 0.6 * math.exp(-0.3 * l)
        x = layer_norm(DEEPNORM_ALPHA * x + 0.5 * swiglu(x, ffn1_w_gu[l], ffn1_w_down[l]), ln_g[l, 0], ln_b[l, 0])
        mix = hybrid_mixer(x, w_in[l], conv_w[l], dn_a_log[l], dn_dt_bias[l], dn_norm_g[l], diff_lambda[l], diff_norm_g[l], sb_norm_g[l], w_out[l], lambda_init)
        x = layer_norm(DEEPNORM_ALPHA * x + mix, ln_g[l, 1], ln_b[l, 1])
        x = layer_norm(DEEPNORM_ALPHA * x + 0.5 * swiglu(x, ffn2_w_gu[l], ffn2_w_down[l]), ln_g[l, 2], ln_b[l, 2])
    return x
```

```cpp
#include <hip/hip_runtime.h>
#include <hip/hip_cooperative_groups.h>
#include <cstdio>
#include <cstdint>
namespace cg = cooperative_groups;

#ifndef MULTI_LAUNCH
#define MULTI_LAUNCH 0
#endif

#define LAS __attribute__((address_space(3)))
typedef unsigned short bf16_t;
typedef short bf16x8 __attribute__((ext_vector_type(8)));
typedef float f32x4 __attribute__((ext_vector_type(4)));
typedef float f32x16 __attribute__((ext_vector_type(16)));
typedef unsigned u32x4 __attribute__((ext_vector_type(4)));
typedef unsigned u32x2 __attribute__((ext_vector_type(2)));

constexpr int T_ = 16384, D_ = 1024, FF_ = 2816, NIN_ = 3592, NING_ = 3584, SEQ_ = 4096;
constexpr float ALPHA_ = 1.4142135623730951f;
constexpr float LN_EPS_ = 1e-5f, RMS_EPS_ = 1e-6f;
constexpr int LDS_BYTES = 131072 + 16;

constexpr size_t SZ_WGU = (size_t)2 * FF_ * D_ * 2;
constexpr size_t SZ_WDN = (size_t)D_ * FF_ * 2;
constexpr size_t SZ_WIN = (size_t)NING_ * D_ * 2;
constexpr size_t SZ_WOUT = (size_t)D_ * D_ * 2;
constexpr size_t OFF_WGU0 = 0;
constexpr size_t OFF_WGU1 = OFF_WGU0 + SZ_WGU;
constexpr size_t OFF_WDN0 = OFF_WGU1 + SZ_WGU;
constexpr size_t OFF_WDN1 = OFF_WDN0 + SZ_WDN;
constexpr size_t OFF_WIN = OFF_WDN1 + SZ_WDN;
constexpr size_t OFF_WOUT = OFF_WIN + SZ_WIN;
constexpr size_t OFF_C12GU0 = OFF_WOUT + SZ_WOUT;
constexpr size_t OFF_C12GU1 = OFF_C12GU0 + (size_t)2 * 5632 * 4;
constexpr size_t OFF_C12IN = OFF_C12GU1 + (size_t)2 * 5632 * 4;
constexpr size_t OFF_WG8 = OFF_C12IN + (size_t)2 * 3584 * 4;
constexpr size_t OFF_STATS = OFF_WG8 + (size_t)(8 * 1024 + 16) * 4;
constexpr size_t OFF_MUR = OFF_STATS + (size_t)6 * T_ * 32 * 4;
constexpr size_t OFF_GATES = OFF_MUR + (size_t)6 * T_ * 2 * 4;
constexpr size_t OFF_EGL = OFF_GATES + (size_t)T_ * 8 * 4;
constexpr size_t OFF_BAR = ((OFF_EGL + 4096 + 255) / 256) * 256;
constexpr size_t BAR_BYTES = 16384;
constexpr size_t OFF_YB = OFF_BAR + BAR_BYTES;
constexpr size_t OFF_R1 = OFF_YB + (size_t)T_ * D_ * 2;
constexpr size_t OFF_H = OFF_R1;
constexpr size_t OFF_QK = OFF_R1;
constexpr size_t OFF_VT = OFF_QK + (size_t)T_ * 1024 * 2;
constexpr size_t OFF_DNW = OFF_R1;
constexpr size_t SZ_DN16 = (size_t)1024 * 64 * 128 * 2;
constexpr size_t OFF_DNQG = OFF_DNW + SZ_DN16;
constexpr size_t OFF_DNKGT = OFF_DNQG + SZ_DN16;
constexpr size_t OFF_DNU = OFF_DNKGT + SZ_DN16;
constexpr size_t OFF_DNA = OFF_DNU + SZ_DN16;
constexpr size_t OFF_PC = OFF_DNA + (size_t)1024 * 64 * 64 * 2;
constexpr size_t OFF_OCRAW = OFF_PC;
constexpr size_t OFF_Z = OFF_PC + (size_t)T_ * 1536 * 2;
constexpr size_t OFF_O = OFF_Z + (size_t)T_ * 512 * 2;
constexpr size_t WS_END = OFF_O + (size_t)T_ * 1024 * 2;
static_assert(OFF_VT + (size_t)2 * 16 * 64 * 4096 * 2 <= OFF_PC, "VT overlaps PC");
static_assert(OFF_H + (size_t)T_ * FF_ * 2 <= WS_END, "h fits");
static_assert(WS_END <= (size_t)268435456, "workspace");

struct Args {
    const float* in[16];
    float* out;
    unsigned char* ws;
    int ph_lo, ph_hi;
};

typedef const __attribute__((address_space(4))) Args& ArgsRef;
struct Tb { int tid, bid, G; };

typedef float f32x2_t __attribute__((ext_vector_type(2)));
typedef __bf16 bf16x2_t __attribute__((ext_vector_type(2)));
__device__ __forceinline__ unsigned pk2(float lo, float hi) { const f32x2_t v = {lo, hi}; const bf16x2_t b = __builtin_convertvector(v, bf16x2_t); return __builtin_bit_cast(unsigned, b); }
__device__ __forceinline__ float bf2f(unsigned b) { return __uint_as_float(b << 16); }
__device__ __forceinline__ float bflo(unsigned w) { return __uint_as_float(w << 16); }
__device__ __forceinline__ float bfhi(unsigned w) { return __uint_as_float(w & 0xffff0000u); }
__device__ __forceinline__ int swap23(int x) { return (x & ~12) | ((x & 4) << 1) | ((x & 8) >> 1); }
__device__ __forceinline__ int crow(int reg, int h) { return (reg & 3) + 8 * (reg >> 2) + 4 * h; }
__device__ __forceinline__ int perm32k(int q) { return ((q >> 2) & 3) * 8 + ((q >> 4) & 1) * 4 + (q & 3); }
#define MFMA16(a, b, c) __builtin_amdgcn_mfma_f32_16x16x32_bf16((a), (b), (c), 0, 0, 0)
#define MFMA32(a, b, c) __builtin_amdgcn_mfma_f32_32x32x16_bf16((a), (b), (c), 0, 0, 0)
__device__ __forceinline__ bf16x8 pack8(const f32x16& x, int s) {
    u32x4 p;
    p[0] = pk2(x[8 * s + 0], x[8 * s + 1]); p[1] = pk2(x[8 * s + 2], x[8 * s + 3]);
    p[2] = pk2(x[8 * s + 4], x[8 * s + 5]); p[3] = pk2(x[8 * s + 6], x[8 * s + 7]);
    return __builtin_bit_cast(bf16x8, p);
}
__device__ __forceinline__ float wave_sum(float v) {
#pragma unroll
    for (int o = 1; o < 64; o <<= 1) v += __shfl_xor(v, o);
    return v;
}

namespace pg8 {
constexpr int BM = 256, BK = 64, HALF = 128, HTB = HALF * BK * 2, STAGE_BYTES = 8 * HTB, NXCD = 8, WGM = 8;
__host__ __device__ __forceinline__ int lds_byte(int r, int c) { const int st = (r >> 4) * 2 + (c >> 5), rr = r & 15, cc = c & 31, ob = rr * 64 + cc * 2; return st * 1024 + (ob ^ (((ob >> 9) & 1) << 5)); }
__host__ __device__ __forceinline__ void stage_rc(int b, int& R, int& C) { const int st = b / 1024, sb = b % 1024, swz = sb ^ (((sb >> 9) & 1) << 5); R = (st >> 1) * 16 + swz / 64; C = (st & 1) * 32 + (swz % 64) / 2; }
struct Unit { int pm, pn; };
struct Gemm { const bf16_t* A; const bf16_t* Bt; int M, N, K; };
struct StaticOrder {
    int nM, nN, nwg, G, c;
    __device__ void init(int M, int N, int G_, int c_) { nM = M / BM; nN = N / BM; nwg = nM * nN; G = G_; c = c_; }
    __device__ bool next(int i, Unit& u) const {
        const long L = (long)i * G + c; if (L >= nwg) return false;
        int wgid = (int)L; { const int q = nwg / NXCD, r = nwg % NXCD, xcd = wgid % NXCD, off = wgid / NXCD; wgid = (xcd < r ? xcd * (q + 1) : r * (q + 1) + (xcd - r) * q) + off; }
        const int nig = WGM * nN, gid = wgid / nig, fm = gid * WGM, gsz = (nM - fm) < WGM ? (nM - fm) : WGM;
        u.pm = fm + ((wgid % nig) % gsz); u.pn = (wgid % nig) / gsz; return true;
    }
};

template <class Epi>
__device__ __forceinline__ void gemm_phase(const Tb tb, LAS unsigned char* lds, const Gemm g, const StaticOrder& S, const Epi& E) {
    const int tid = tb.tid, wid = __builtin_amdgcn_readfirstlane(tid >> 6), lane = tid & 63, wr = wid >> 2, wc = wid & 3, fr = lane & 15, fq = lane >> 4;
    const int K = g.K, nt = K / BK;
    unsigned voffA[2], voffB[2];
#pragma unroll
    for (int i = 0; i < 2; ++i) { int R, C; stage_rc(tid * 16 + i * 8192, R, C); voffA[i] = (unsigned)(R * K + C) * 2u; voffB[i] = voffA[i]; }
    const size_t kstep = (size_t)(BK * 2);
    const size_t hstep = (size_t)HALF * K * 2;
    const size_t tstep = 2 * hstep;
    const unsigned ldsw = (unsigned)wid * 1024u;
    const int aoff = lds_byte(wr * 64 + fr, fq * 8), boff = lds_byte(wc * 32 + fr, fq * 8);
#define PG8_SA(b, h) (((b) * 2 + (h)) * HTB)
#define PG8_SB(b, h) ((4 + (b) * 2 + (h)) * HTB)
#define PG8_STAGE(bufoff, gbase, voff) do { _Pragma("unroll") for (int _i = 0; _i < 2; ++_i) \
        __builtin_amdgcn_global_load_lds((const unsigned*)((const char*)(gbase) + (voff)[_i]), (LAS unsigned*)(lds + (bufoff) + ldsw + _i * 8192), 16, 0, 0); } while (0)
#define PG8_LDA(dst, b, h) do { _Pragma("unroll") for (int m = 0; m < 4; ++m) _Pragma("unroll") for (int k = 0; k < 2; ++k) dst[m][k] = *(const LAS bf16x8*)(lds + PG8_SA(b, h) + aoff + m * 2048 + k * 1024); } while (0)
#define PG8_LDB(dst, b, h) do { _Pragma("unroll") for (int n = 0; n < 2; ++n) _Pragma("unroll") for (int k = 0; k < 2; ++k) dst[n][k] = *(const LAS bf16x8*)(lds + PG8_SB(b, h) + boff + n * 2048 + k * 1024); } while (0)
#define PG8_MMA(ai, bj, At, Bt) do { __builtin_amdgcn_s_setprio(1); _Pragma("unroll") for (int m = 0; m < 4; ++m) _Pragma("unroll") for (int n = 0; n < 2; ++n) _Pragma("unroll") for (int k = 0; k < 2; ++k) \
        acc[ai][bj][m][n] = __builtin_amdgcn_mfma_f32_16x16x32_bf16(Bt[n][k], At[m][k], acc[ai][bj][m][n], 0, 0, 0); __builtin_amdgcn_s_setprio(0); } while (0)
#define PG8_WAIT_V(n) asm volatile("s_waitcnt vmcnt(" #n ")" ::: "memory")
#define PG8_WAIT_L(n) asm volatile("s_waitcnt lgkmcnt(" #n ")" ::: "memory")
#define PG8_BAR __builtin_amdgcn_s_barrier()
#define PG8_SCHED __builtin_amdgcn_sched_barrier(0)
    Unit cur, nxt; int ui = 0;
    if (!S.next(0, cur)) return;
    f32x4 acc[2][2][4][2];
#pragma unroll
    for (int a = 0; a < 2; ++a)
#pragma unroll
        for (int b = 0; b < 2; ++b)
#pragma unroll
            for (int m = 0; m < 4; ++m)
#pragma unroll
                for (int n = 0; n < 2; ++n) acc[a][b][m][n] = (f32x4){0.f, 0.f, 0.f, 0.f};
    bf16x8 At[4][2], B0[2][2], B1[2][2];
    const char* cA = (const char*)g.A + (size_t)cur.pm * tstep; const char* cB = (const char*)g.Bt + (size_t)cur.pn * tstep;
    PG8_STAGE(PG8_SB(0, 0), cB, voffB); PG8_STAGE(PG8_SA(0, 0), cA, voffA); PG8_STAGE(PG8_SB(0, 1), cB + hstep, voffB); PG8_STAGE(PG8_SA(0, 1), cA + hstep, voffA);
    if (wr == 1) PG8_BAR;
    PG8_WAIT_V(4); PG8_BAR;
    PG8_STAGE(PG8_SB(1, 0), cB + kstep, voffB); PG8_STAGE(PG8_SA(1, 0), cA + kstep, voffA); PG8_STAGE(PG8_SB(1, 1), cB + hstep + kstep, voffB);
    PG8_WAIT_V(6); PG8_BAR;
    for (;;) {
        const bool has_next = S.next(ui + 1, nxt);
        const char* nA = has_next ? (const char*)g.A + (size_t)nxt.pm * tstep : cA; const char* nB = has_next ? (const char*)g.Bt + (size_t)nxt.pn * tstep : cB;
        for (int t = 0; t < nt; t += 2) {
            const bool last = (t == nt - 2);
            const char* a1 = cA + (size_t)(t + 1) * kstep;
            const char* a2 = last ? nA : cA + (size_t)(t + 2) * kstep; const char* b2 = last ? nB : cB + (size_t)(t + 2) * kstep;
            const char* a3 = a2 + kstep; const char* b3 = b2 + kstep;
            PG8_LDB(B0, 0, 0); PG8_SCHED; PG8_LDA(At, 0, 0); PG8_STAGE(PG8_SA(1, 1), a1 + hstep, voffA);
            PG8_WAIT_L(8); PG8_BAR; PG8_WAIT_L(0); PG8_MMA(0, 0, At, B0); PG8_BAR; PG8_SCHED;
            PG8_LDB(B1, 0, 1); PG8_STAGE(PG8_SB(0, 0), b2, voffB);
            PG8_BAR; PG8_WAIT_L(0); PG8_MMA(0, 1, At, B1); PG8_BAR;
            PG8_LDA(At, 0, 1); PG8_STAGE(PG8_SA(0, 0), a2, voffA);
            PG8_BAR; PG8_WAIT_L(0); PG8_MMA(1, 0, At, B0); PG8_BAR; PG8_SCHED;
            PG8_STAGE(PG8_SB(0, 1), b2 + hstep, voffB);
            PG8_WAIT_V(6); PG8_BAR; PG8_MMA(1, 1, At, B1); PG8_BAR;
            PG8_LDB(B0, 1, 0); PG8_SCHED; PG8_LDA(At, 1, 0); PG8_STAGE(PG8_SA(0, 1), a2 + hstep, voffA);
            PG8_WAIT_L(8); PG8_BAR; PG8_WAIT_L(0); PG8_MMA(0, 0, At, B0); PG8_BAR; PG8_SCHED;
            PG8_LDB(B1, 1, 1); PG8_STAGE(PG8_SB(1, 0), b3, voffB);
            PG8_BAR; PG8_WAIT_L(0); PG8_MMA(0, 1, At, B1); PG8_BAR;
            PG8_LDA(At, 1, 1); PG8_STAGE(PG8_SA(1, 0), a3, voffA);
            PG8_BAR; PG8_WAIT_L(0); PG8_MMA(1, 0, At, B0); PG8_BAR; PG8_SCHED;
            PG8_STAGE(PG8_SB(1, 1), b3 + hstep, voffB);
            PG8_WAIT_V(6); PG8_BAR; PG8_MMA(1, 1, At, B1); PG8_BAR;
        }
        E(acc, cur, wr, wc, fr, fq);
        if (!has_next) break;
#pragma unroll
        for (int a = 0; a < 2; ++a)
#pragma unroll
            for (int b = 0; b < 2; ++b)
#pragma unroll
                for (int m = 0; m < 4; ++m)
#pragma unroll
                    for (int n = 0; n < 2; ++n) acc[a][b][m][n] = (f32x4){0.f, 0.f, 0.f, 0.f};
        cur = nxt; cA = nA; cB = nB; ++ui;
    }
    PG8_WAIT_V(0);
    if (wr == 0) PG8_BAR;
    PG8_BAR;
#undef PG8_SA
#undef PG8_SB
#undef PG8_STAGE
#undef PG8_LDA
#undef PG8_LDB
#undef PG8_MMA
#undef PG8_WAIT_V
#undef PG8_WAIT_L
#undef PG8_BAR
#undef PG8_SCHED
}
}

__device__ __forceinline__ void row_stats(const float* mur, int row, float& mu, float& rstd) {
    if (mur) { const float2 v = *(const float2*)(mur + 2 * (size_t)row); mu = v.x; rstd = v.y; }
    else { mu = 0.f; rstd = 1.f; }
}
__device__ __forceinline__ void phase_statsfin(ArgsRef a, const Tb tb, int inst) {
    const float* part = (const float*)(a.ws + OFF_STATS) + (size_t)inst * T_ * 32;
    float* mur = (float*)(a.ws + OFF_MUR) + (size_t)inst * T_ * 2;
    const int gt = tb.bid * 512 + tb.tid, GT = tb.G * 512;
    for (int i = gt; i < T_ * 8; i += GT) {
        const int row = i >> 3, sub = i & 7;
        const f32x4 v = *(const f32x4*)(part + (size_t)row * 32 + sub * 4);
        float s = v[0] + v[2], q = v[1] + v[3];
        s += __shfl_xor(s, 1); q += __shfl_xor(q, 1); s += __shfl_xor(s, 2); q += __shfl_xor(q, 2); s += __shfl_xor(s, 4); q += __shfl_xor(q, 4);
        if (sub == 0) { const float mu = s * (1.f / 1024.f); const float var = fmaxf(q * (1.f / 1024.f) - mu * mu, 0.f); float2 o; o.x = mu; o.y = rsqrtf(var + LN_EPS_); *(float2*)(mur + 2 * (size_t)row) = o; }
    }
}
struct EpiGU {
    bf16_t* H; const float* stats; const float* c1; const float* c2;
    __device__ __forceinline__ void operator()(const f32x4 (&acc)[2][2][4][2], const pg8::Unit& u, int wr, int wc, int fr, int fq) const {
        const int row0 = u.pm * 256 + wr * 64 + fr, hcol0 = u.pn * 128 + wc * 32 + 4 * fq, ci0 = u.pn * 256 + wc * 32 + 4 * fq;
        f32x4 c1g[2], c2g[2], c1u[2], c2u[2];
#pragma unroll
        for (int n = 0; n < 2; ++n) { c1g[n] = *(const f32x4*)(c1 + ci0 + 16 * n); c2g[n] = *(const f32x4*)(c2 + ci0 + 16 * n); c1u[n] = *(const f32x4*)(c1 + ci0 + 128 + 16 * n); c2u[n] = *(const f32x4*)(c2 + ci0 + 128 + 16 * n); }
#pragma unroll
        for (int ai = 0; ai < 2; ++ai)
#pragma unroll
            for (int m = 0; m < 4; ++m) {
                const int row = row0 + ai * 128 + m * 16; float mu, rstd; row_stats(stats, row, mu, rstd);
#pragma unroll
                for (int n = 0; n < 2; ++n) {
                    float hv[4];
#pragma unroll
                    for (int j = 0; j < 4; ++j) {
                        const float gt = rstd * (acc[ai][0][m][n][j] - mu * c1g[n][j]) + c2g[n][j];
                        const float up = rstd * (acc[ai][1][m][n][j] - mu * c1u[n][j]) + c2u[n][j];
                        hv[j] = gt * __builtin_amdgcn_rcpf(1.f + __expf(-gt)) * up;
                    }
                    u32x2 w; w.x = pk2(hv[0], hv[1]); w.y = pk2(hv[2], hv[3]);
                    *(u32x2*)(H + (size_t)row * FF_ + hcol0 + 16 * n) = w;
                }
            }
    }
};
struct EpiRes {
    float* Yout; bf16_t* YB; const float* stats_prev; const float* lng; const float* lnb; float* stats_new; float coef;
    __device__ __forceinline__ void operator()(const f32x4 (&acc)[2][2][4][2], const pg8::Unit& u, int wr, int wc, int fr, int fq) const {
        const int row0 = u.pm * 256 + wr * 64 + fr, col0 = u.pn * 256 + wc * 32 + 4 * fq;
#pragma unroll
        for (int ai = 0; ai < 2; ++ai)
#pragma unroll
            for (int m = 0; m < 4; ++m) {
                const int row = row0 + ai * 128 + m * 16; float mu, rstd; row_stats(stats_prev, row, mu, rstd);
                float s = 0.f, q = 0.f;
#pragma unroll
                for (int bj = 0; bj < 2; ++bj)
#pragma unroll
                    for (int n = 0; n < 2; ++n) {
                        const int col = col0 + bj * 128 + n * 16;
                        const u32x2 rb = *(const u32x2*)(YB + (size_t)row * D_ + col);
                        f32x4 r = (f32x4){bflo(rb.x), bfhi(rb.x), bflo(rb.y), bfhi(rb.y)};
                        if (stats_prev) { const f32x4 g4 = *(const f32x4*)(lng + col), b4 = *(const f32x4*)(lnb + col); r = (r - mu) * rstd * g4 + b4; }
                        const f32x4 y = r * ALPHA_ + acc[ai][bj][m][n] * coef;
                        if (Yout) *(f32x4*)(Yout + (size_t)row * D_ + col) = y;
                        else { u32x2 w; w.x = pk2(y[0], y[1]); w.y = pk2(y[2], y[3]); *(u32x2*)(YB + (size_t)row * D_ + col) = w; }
                        s += (y[0] + y[1]) + (y[2] + y[3]); q += (y[0] * y[0] + y[1] * y[1]) + (y[2] * y[2] + y[3] * y[3]);
                    }
                s += __shfl_xor(s, 16); s += __shfl_xor(s, 32); q += __shfl_xor(q, 16); q += __shfl_xor(q, 32);
                if (fq == 0) { float2 sq; sq.x = s; sq.y = q; *(float2*)(stats_new + (size_t)row * 32 + (u.pn * 4 + wc) * 2) = sq; }
            }
    }
};
struct EpiIn {
    const float* stats; const float* c1; const float* c2; bf16_t* QK; bf16_t* VT; bf16_t* PC; bf16_t* Z;
    __device__ __forceinline__ void operator()(const f32x4 (&acc)[2][2][4][2], const pg8::Unit& u, int wr, int wc, int fr, int fq) const {
        const int row0 = u.pm * 256 + wr * 64 + fr, cc0 = wc * 32 + 4 * fq, pn = u.pn;
        const float* c1p = c1 + pn * 256 + cc0; const float* c2p = c2 + pn * 256 + cc0;
        const bool isv = (pn == 2 || pn == 5);
        bf16_t* dst; unsigned ld;
        if (pn < 2) { dst = QK + pn * 256; ld = 1024; }
        else if (pn == 3 || pn == 4) { dst = QK + (pn - 1) * 256; ld = 1024; }
        else if (pn >= 12) { dst = Z + (pn - 12) * 256; ld = 512; }
        else if (isv) { dst = VT + (size_t)(pn == 5 ? 16 : 0) * 64 * 4096; ld = 0; }
        else { dst = PC + (pn - 6) * 256; ld = 1536; }
#pragma unroll 1
        for (int ai = 0; ai < 2; ++ai)
#pragma unroll
            for (int m = 0; m < 4; ++m) {
                const int row = row0 + ai * 128 + m * 16; float mu, rstd; row_stats(stats, row, mu, rstd);
                const unsigned vrow = (unsigned)(row >> 12) * (4u * 64u * 4096u) + (unsigned)(row & 4095);
#pragma unroll
                for (int bj = 0; bj < 2; ++bj)
#pragma unroll
                    for (int n = 0; n < 2; ++n) {
                        const int cc = bj * 128 + n * 16;
                        const f32x4 c1q = *(const f32x4*)(c1p + cc), c2q = *(const f32x4*)(c2p + cc);
                        const f32x4 a4 = ai ? acc[1][bj][m][n] : acc[0][bj][m][n];
                        const f32x4 v = (a4 - c1q * mu) * rstd + c2q;
                        const unsigned w0 = pk2(v[0], v[1]), w1 = pk2(v[2], v[3]);
                        if (!isv) { u32x2 w; w.x = w0; w.y = w1; *(u32x2*)(dst + ((unsigned)row * ld + (unsigned)(cc0 + cc))) = w; }
                        else {
                            bf16_t* p = dst + (vrow + (unsigned)(cc0 + cc) * 4096u);
                            p[0] = (bf16_t)(w0 & 0xffff); p[4096] = (bf16_t)(w0 >> 16); p[2 * 4096] = (bf16_t)(w1 & 0xffff); p[3 * 4096] = (bf16_t)(w1 >> 16);
                        }
                    }
            }
    }
};

__device__ __forceinline__ void pro_item(const Tb tb, const float* W, int K, int N, int src0, bf16_t* Bt, int dst0, const float* lng, const float* lnb, float* c1, float* c2, LAS float* tile, int kbeg, int kend) {
    const int tid = tb.tid, kk = tid >> 4, n4 = (tid & 15) * 4, n = tid >> 3, ks = (tid & 7) * 8;
    float s1 = 0.f, s2 = 0.f;
    const float* wp = W + (size_t)kk * N + src0 + n4;
    f32x4 nx0 = *(const f32x4*)(wp + (size_t)kbeg * N), nx1 = *(const f32x4*)(wp + (size_t)(kbeg + 32) * N);
    for (int k0 = kbeg; k0 < kend; k0 += 64) {
        const f32x4 v0 = nx0, v1 = nx1;
        if (k0 + 64 < kend) { nx0 = *(const f32x4*)(wp + (size_t)(k0 + 64) * N); nx1 = *(const f32x4*)(wp + (size_t)(k0 + 96) * N); }
        tile[(n4 + 0) * 65 + kk] = v0[0]; tile[(n4 + 1) * 65 + kk] = v0[1]; tile[(n4 + 2) * 65 + kk] = v0[2]; tile[(n4 + 3) * 65 + kk] = v0[3];
        tile[(n4 + 0) * 65 + kk + 32] = v1[0]; tile[(n4 + 1) * 65 + kk + 32] = v1[1]; tile[(n4 + 2) * 65 + kk + 32] = v1[2]; tile[(n4 + 3) * 65 + kk + 32] = v1[3];
        __syncthreads();
        float v[8];
#pragma unroll
        for (int j = 0; j < 8; ++j) v[j] = tile[n * 65 + ks + j];
        if (lng) {
#pragma unroll
            for (int j = 0; j < 8; ++j) { s2 += lnb[k0 + ks + j] * v[j]; v[j] *= lng[k0 + ks + j]; }
        }
        u32x4 o; o[0] = pk2(v[0], v[1]); o[1] = pk2(v[2], v[3]); o[2] = pk2(v[4], v[5]); o[3] = pk2(v[6], v[7]);
#pragma unroll
        for (int j = 0; j < 4; ++j) s1 += bflo(o[j]) + bfhi(o[j]);
        *(u32x4*)(Bt + (size_t)(dst0 + n) * K + k0 + ks) = o;
        __syncthreads();
    }
    s1 += __shfl_xor(s1, 1); s1 += __shfl_xor(s1, 2); s1 += __shfl_xor(s1, 4);
    s2 += __shfl_xor(s2, 1); s2 += __shfl_xor(s2, 2); s2 += __shfl_xor(s2, 4);
    if (c1 && (tid & 7) == 0) { c1[dst0 + n] = s1; c2[dst0 + n] = s2; }
}

__device__ __forceinline__ void pro_part(ArgsRef a, const Tb tb, int l, int part, int vb, int VG, LAS unsigned char* lds) {
    unsigned char* ws = a.ws;
    LAS float* tile = (LAS float*)lds;
    const float* ln_g = a.in[5]; const float* ln_b = a.in[6];
    const float* g_ffn1 = l > 0 ? ln_g + ((l - 1) * 3 + 2) * D_ : nullptr; const float* b_ffn1 = l > 0 ? ln_b + ((l - 1) * 3 + 2) * D_ : nullptr;
    const float* g_mix = ln_g + (l * 3 + 0) * D_; const float* b_mix = ln_b + (l * 3 + 0) * D_;
    const float* g_ffn2 = ln_g + (l * 3 + 1) * D_; const float* b_ffn2 = ln_b + (l * 3 + 1) * D_;
    if (part == 0) {
        for (int it = vb; it < 208; it += VG) {
            int r = it;
            if (r < 88) {
                const int np = r * 64, pn = np >> 8, bj = (np >> 7) & 1, x = np & 127, src = bj * FF_ + 128 * pn + x;
                float* c12 = (float*)(ws + OFF_C12GU0);
                pro_item(tb, a.in[1] + (size_t)l * D_ * 2 * FF_, D_, 2 * FF_, src, (bf16_t*)(ws + OFF_WGU0), np, g_ffn1, b_ffn1, c12, c12 + 5632, tile, 0, D_);
                continue;
            }
            r -= 88;
            if (r < 56) { float* c12 = (float*)(ws + OFF_C12IN); pro_item(tb, a.in[7] + (size_t)l * D_ * NIN_, D_, NIN_, r * 64, (bf16_t*)(ws + OFF_WIN), r * 64, g_mix, b_mix, c12, c12 + 3584, tile, 0, D_); continue; }
            r -= 56;
            { const int q = (r >> 2) & 15, kq = r & 3;
              pro_item(tb, a.in[2] + (size_t)l * FF_ * D_, FF_, D_, q * 64, (bf16_t*)(ws + OFF_WDN0), q * 64, nullptr, nullptr, nullptr, nullptr, tile, kq * 704, kq * 704 + 704); }
        }
        if (vb == VG - 1) {
            const int wv = tb.tid >> 6, lane = tb.tid & 63;
            float* wg8 = (float*)(ws + OFF_WG8);
            const float* W = a.in[7] + (size_t)l * D_ * NIN_;
            float s1 = 0.f, s2 = 0.f;
            for (int k = lane; k < D_; k += 64) { const float w = W[(size_t)k * NIN_ + NING_ + wv]; const float wgv = w * g_mix[k]; wg8[wv * 1024 + k] = wgv; s1 += wgv; s2 += b_mix[k] * w; }
            s1 = wave_sum(s1); s2 = wave_sum(s2);
            if (lane == 0) { wg8[8192 + wv] = s1; wg8[8192 + 8 + wv] = s2; }
        }
        if (l == 0) {
            const size_t gt = (size_t)vb * 512 + tb.tid, GT = (size_t)VG * 512;
            const f32x4* x4 = (const f32x4*)a.in[0]; u32x2* yb = (u32x2*)(ws + OFF_YB);
            for (size_t i = gt; i < (size_t)T_ * D_ / 4; i += GT) { const f32x4 v = x4[i]; u32x2 w; w.x = pk2(v[0], v[1]); w.y = pk2(v[2], v[3]); yb[i] = w; }
        }
    } else {
        for (int it = vb; it < 168; it += VG) {
            int r = it;
            if (r < 88) {
                const int np = r * 64, pn = np >> 8, bj = (np >> 7) & 1, x = np & 127, src = bj * FF_ + 128 * pn + x;
                float* c12 = (float*)(ws + OFF_C12GU1);
                pro_item(tb, a.in[3] + (size_t)l * D_ * 2 * FF_, D_, 2 * FF_, src, (bf16_t*)(ws + OFF_WGU1), np, g_ffn2, b_ffn2, c12, c12 + 5632, tile, 0, D_);
                continue;
            }
            r -= 88;
            if (r < 16) { pro_item(tb, a.in[15] + (size_t)l * D_ * D_, D_, D_, r * 64, (bf16_t*)(ws + OFF_WOUT), r * 64, nullptr, nullptr, nullptr, nullptr, tile, 0, D_); continue; }
            r -= 16;
            { const int q = (r >> 2) & 15, kq = r & 3;
              pro_item(tb, a.in[4] + (size_t)l * FF_ * D_, FF_, D_, q * 64, (bf16_t*)(ws + OFF_WDN1), q * 64, nullptr, nullptr, nullptr, nullptr, tile, kq * 704, kq * 704 + 704); }
        }
    }
}

__device__ __forceinline__ void phase_gates(ArgsRef a, const Tb tb, int l) {
    unsigned char* ws = a.ws;
    const float* wg8 = (const float*)(ws + OFF_WG8);
    const float* stats = (const float*)(ws + OFF_MUR) + (size_t)(l * 3 + 0) * T_ * 2;
    float* gates = (float*)(ws + OFF_GATES);
    const bf16_t* YBp = (const bf16_t*)(ws + OFF_YB);
    const int wv = tb.tid >> 6, lane = tb.tid & 63;
    const int gw = tb.bid * 8 + wv, GW = tb.G * 8;
    for (int t = gw; t < T_; t += GW) {
        f32x4 y[4];
#pragma unroll
        for (int i = 0; i < 4; ++i) { const u32x2 rb = *(const u32x2*)(YBp + (size_t)t * D_ + i * 256 + lane * 4); y[i] = (f32x4){bflo(rb.x), bfhi(rb.x), bflo(rb.y), bfhi(rb.y)}; }
        float mu, rstd; row_stats(stats, t, mu, rstd);
        float s8[8];
#pragma unroll
        for (int j = 0; j < 8; ++j) { float s = 0.f;
#pragma unroll
            for (int i = 0; i < 4; ++i) { const f32x4 w = *(const f32x4*)(wg8 + j * 1024 + i * 256 + lane * 4); s += (y[i][0] * w[0] + y[i][1] * w[1]) + (y[i][2] * w[2] + y[i][3] * w[3]); }
            s8[j] = s; }
        const bool b5 = (lane & 32) != 0, b4 = (lane & 16) != 0, b3 = (lane & 8) != 0;
        float r4[4], q2[2];
#pragma unroll
        for (int j = 0; j < 4; ++j) { const float keep = b5 ? s8[j + 4] : s8[j], send = b5 ? s8[j] : s8[j + 4]; r4[j] = keep + __shfl_xor(send, 32); }
#pragma unroll
        for (int j = 0; j < 2; ++j) { const float keep = b4 ? r4[j + 2] : r4[j], send = b4 ? r4[j] : r4[j + 2]; q2[j] = keep + __shfl_xor(send, 16); }
        float dv = (b3 ? q2[1] : q2[0]) + __shfl_xor(b3 ? q2[0] : q2[1], 8);
        dv += __shfl_xor(dv, 4); dv += __shfl_xor(dv, 2); dv += __shfl_xor(dv, 1);
        if ((lane & 7) == 0) {
            const int j = lane >> 3;
            const float v = rstd * (dv - mu * wg8[8192 + j]) + wg8[8192 + 8 + j];
            float o;
            if (j < 4) o = 1.f / (1.f + expf(-v));
            else { const int h = j - 4; const float xx = v + a.in[10][l * 4 + h]; const float sp = fmaxf(xx, 0.f) + log1pf(expf(-fabsf(xx))); o = -expf(a.in[9][l * 4 + h]) * sp; }
            gates[(size_t)t * 8 + (j < 4 ? 4 + j : j - 4)] = o;
        }
    }
}

__device__ __forceinline__ float xor32_max(float v) { const unsigned u = __float_as_uint(v); auto r = __builtin_amdgcn_permlane32_swap(u, u, false, false); return fmaxf(__uint_as_float(r[0]), __uint_as_float(r[1])); }
__device__ __forceinline__ float xor32_get(float v, int h) { const unsigned u = __float_as_uint(v); auto r = __builtin_amdgcn_permlane32_swap(u, u, false, false); return __uint_as_float(h ? r[0] : r[1]); }
__device__ __forceinline__ bf16x8 ldg8(const bf16_t* p) { return *(const bf16x8*)p; }
__device__ __forceinline__ bf16x8 ldsf(LAS const unsigned char* p) { return *(LAS const bf16x8*)p; }
constexpr int AT_ROW = 144, AT_K = 0, AT_V = 64 * AT_ROW, AT_BUF = 2 * 64 * AT_ROW;

template <bool DIAG>
__device__ __forceinline__ void diff_subtile(const bf16x8 (&kf)[4], const bf16x8 (&v)[2][2], const bf16x8 (&q1)[2], const bf16x8 (&q2)[2], f32x16 (&o1)[2], f32x16 (&o2)[2],
                                             float& m1, float& m2, float& l1, float& l2, int r, int h) {
    const float c = 0.17677669529663687f * 1.4426950408889634f;
    const float LAZY_THR = 8.f / c;
    const bf16x8 k1[2] = {kf[0], kf[1]}, k2[2] = {kf[2], kf[3]};
    f32x16 s1, s2;
#pragma unroll
    for (int i = 0; i < 16; ++i) { s1[i] = 0.f; s2[i] = 0.f; }
    s1 = MFMA32(k1[0], q1[0], s1); s1 = MFMA32(k1[1], q1[1], s1);
    s2 = MFMA32(k2[0], q2[0], s2); s2 = MFMA32(k2[1], q2[1], s2);
    if (DIAG) {
#pragma unroll
        for (int i = 0; i < 16; ++i) { const int kk = 16 * (i >> 3) + 8 * h + (i & 7); if (kk > r) { s1[i] = -INFINITY; s2[i] = -INFINITY; } }
    }
    {
        float mx = s1[0];
#pragma unroll
        for (int i = 1; i < 16; ++i) mx = fmaxf(mx, s1[i]);
        mx = xor32_max(mx);
        if (__any(mx > m1 + LAZY_THR)) {
            const float mn = fmaxf(m1, mx), al = exp2f((m1 - mn) * c); m1 = mn; l1 *= al;
#pragma unroll
            for (int i = 0; i < 16; ++i) { o1[0][i] *= al; o1[1][i] *= al; }
        }
        float ls = 0.f; const float mc = m1 * c;
#pragma unroll
        for (int i = 0; i < 16; ++i) { s1[i] = __builtin_amdgcn_exp2f(s1[i] * c - mc); ls += s1[i]; }
        l1 += ls;
        const bf16x8 p0 = pack8(s1, 0), p1 = pack8(s1, 1);
        o1[0] = MFMA32(v[0][0], p0, o1[0]); o1[0] = MFMA32(v[0][1], p1, o1[0]);
        o1[1] = MFMA32(v[1][0], p0, o1[1]); o1[1] = MFMA32(v[1][1], p1, o1[1]);
    }
    {
        float mx = s2[0];
#pragma unroll
        for (int i = 1; i < 16; ++i) mx = fmaxf(mx, s2[i]);
        mx = xor32_max(mx);
        if (__any(mx > m2 + LAZY_THR)) {
            const float mn = fmaxf(m2, mx), al = exp2f((m2 - mn) * c); m2 = mn; l2 *= al;
#pragma unroll
            for (int i = 0; i < 16; ++i) { o2[0][i] *= al; o2[1][i] *= al; }
        }
        float ls = 0.f; const float mc = m2 * c;
#pragma unroll
        for (int i = 0; i < 16; ++i) { s2[i] = __builtin_amdgcn_exp2f(s2[i] * c - mc); ls += s2[i]; }
        l2 += ls;
        const bf16x8 p0 = pack8(s2, 0), p1 = pack8(s2, 1);
        o2[0] = MFMA32(v[0][0], p0, o2[0]); o2[0] = MFMA32(v[0][1], p1, o2[0]);
        o2[1] = MFMA32(v[1][0], p0, o2[1]); o2[1] = MFMA32(v[1][1], p1, o2[1]);
    }
}

template <bool DIAG>
__device__ __forceinline__ void stick_subtile(const bf16x8 (&k)[4], const bf16x8 (&v)[2][2], const bf16x8 (&q)[4], f32x16 (&o)[2], float& run, int r, int h) {
    f32x16 z;
#pragma unroll
    for (int i = 0; i < 16; ++i) z[i] = 0.f;
#pragma unroll
    for (int s = 0; s < 4; ++s) z = MFMA32(k[s], q[s], z);
    f32x16 be, sy;
#pragma unroll
    for (int i = 0; i < 16; ++i) { const float t = __expf(-fmaxf(z[i] * 0.125f, -80.f)); const float rc = __builtin_amdgcn_rcpf(1.f + t); be[i] = rc; sy[i] = t * rc; }
    if (DIAG) {
#pragma unroll
        for (int i = 0; i < 16; ++i) { const int kk = 16 * (i >> 3) + 8 * h + (i & 7); if (kk >= r) { be[i] = 0.f; sy[i] = 1.f; } }
    }
    f32x16 suf; float tot[2];
#pragma unroll
    for (int gq = 0; gq < 2; ++gq) {
        float acc = 1.f;
#pragma unroll
        for (int j = 7; j >= 0; --j) { suf[8 * gq + j] = acc; acc *= sy[8 * gq + j]; }
        tot[gq] = acc;
    }
    const float pt0 = xor32_get(tot[0], h), pt1 = xor32_get(tot[1], h);
    const float after0 = run * (h ? (pt1 * tot[1]) : (pt0 * tot[1] * pt1));
    const float after1 = run * (h ? 1.f : pt1);
    f32x16 w;
#pragma unroll
    for (int i = 0; i < 16; ++i) w[i] = be[i] * (i < 8 ? after0 : after1) * suf[i];
    run *= (tot[0] * tot[1]) * (pt0 * pt1);
    const bf16x8 p0 = pack8(w, 0), p1 = pack8(w, 1);
    o[0] = MFMA32(v[0][0], p0, o[0]); o[0] = MFMA32(v[0][1], p1, o[0]);
    o[1] = MFMA32(v[1][0], p0, o[1]); o[1] = MFMA32(v[1][1], p1, o[1]);
}

template <int TYPE>
__device__ __forceinline__ void attn_unit(const bf16_t* QK, const bf16_t* VT, bf16_t* O, int bh, int qb, float lam, const float* normg, float outscale, int tid, LAS unsigned char* lds) {
    const int wv = tid >> 6, lane = tid & 63, r = lane & 31, h = lane >> 5, b = bh >> 2, hd = bh & 3;
    const int qg = qb * 8 + wv, q0 = qg * 32, ntile = (qb + 1) * 4;
    const size_t tok0 = (size_t)b * SEQ_;
    const bf16_t* qrow = QK + (tok0 + q0 + r) * 1024 + (TYPE ? 512 : 0) + hd * 64;
    bf16x8 q[4];
#pragma unroll
    for (int s = 0; s < 4; ++s) q[s] = ldg8(qrow + 16 * s + 8 * h);
    const bf16_t* kg = QK + (tok0 + (tid >> 3)) * 1024 + (TYPE ? 768 : 256) + hd * 64 + (tid & 7) * 8;
    const bf16_t* vg = VT + ((size_t)(TYPE ? 16 : 0) + bh) * 64 * 4096 + (size_t)(tid >> 3) * 4096 + (tid & 7) * 8;
    const unsigned lk = AT_K + (tid >> 3) * AT_ROW + (tid & 7) * 16, lv = AT_V + (tid >> 3) * AT_ROW + (tid & 7) * 16;
    const unsigned fk = AT_K + swap23(r) * AT_ROW + 16 * h, fv = AT_V + r * AT_ROW + 16 * h;
    f32x16 o1[2], o2[2];
#pragma unroll
    for (int i = 0; i < 16; ++i) { o1[0][i] = 0.f; o1[1][i] = 0.f; o2[0][i] = 0.f; o2[1][i] = 0.f; }
    float m1 = -INFINITY, m2 = -INFINITY, l1 = 0.f, l2 = 0.f, run = 1.f;
    {
        const int tt = TYPE ? ntile - 1 : 0;
        const u32x4 kx = *(const u32x4*)(kg + (size_t)tt * 64 * 1024), vx = *(const u32x4*)(vg + tt * 64);
        *(LAS u32x4*)(lds + lk) = kx; *(LAS u32x4*)(lds + lv) = vx;
    }
    __syncthreads();
    for (int it = 0; it < ntile; ++it) {
        const int tt = TYPE ? ntile - 1 - it : it;
        u32x4 kx, vx;
        if (it + 1 < ntile) { const int tn = TYPE ? tt - 1 : tt + 1; kx = *(const u32x4*)(kg + (size_t)tn * 64 * 1024); vx = *(const u32x4*)(vg + tn * 64); }
        LAS const unsigned char* L = lds + (it & 1) * AT_BUF;
        bf16x8 kf[2][4], vf[2][2][2];
#pragma unroll
        for (int st = 0; st < 2; ++st) {
#pragma unroll
            for (int s4 = 0; s4 < 4; ++s4) kf[st][s4] = ldsf(L + fk + st * 32 * AT_ROW + 32 * s4);
#pragma unroll
            for (int mt = 0; mt < 2; ++mt)
#pragma unroll
                for (int s2 = 0; s2 < 2; ++s2) vf[st][mt][s2] = ldsf(L + fv + st * 64 + mt * 32 * AT_ROW + 32 * s2);
        }
#pragma unroll
        for (int ss = 0; ss < 2; ++ss) {
            const int st = TYPE ? 1 - ss : ss, kt = 2 * tt + st;
            const bf16x8 (&qa)[2] = *(const bf16x8 (*)[2])&q[0]; const bf16x8 (&qb2)[2] = *(const bf16x8 (*)[2])&q[2];
            if (kt < qg) {
                if (TYPE == 0) diff_subtile<false>(kf[st], vf[st], qa, qb2, o1, o2, m1, m2, l1, l2, r, h);
                else stick_subtile<false>(kf[st], vf[st], q, o1, run, r, h);
            } else if (kt == qg) {
                if (TYPE == 0) diff_subtile<true>(kf[st], vf[st], qa, qb2, o1, o2, m1, m2, l1, l2, r, h);
                else stick_subtile<true>(kf[st], vf[st], q, o1, run, r, h);
            }
        }
        if (it + 1 < ntile) { LAS unsigned char* Ln = lds + ((it + 1) & 1) * AT_BUF; *(LAS u32x4*)(Ln + lk) = kx; *(LAS u32x4*)(Ln + lv) = vx; }
        __syncthreads();
    }
    float ss = 0.f;
    if (TYPE == 0) {
        l1 += __shfl_xor(l1, 32); l2 += __shfl_xor(l2, 32);
        const float i1 = 1.f / l1, i2 = lam / l2;
#pragma unroll
        for (int mt = 0; mt < 2; ++mt)
#pragma unroll
            for (int i = 0; i < 16; ++i) { const float vv = o1[mt][i] * i1 - o2[mt][i] * i2; o1[mt][i] = vv; ss += vv * vv; }
    } else {
#pragma unroll
        for (int mt = 0; mt < 2; ++mt)
#pragma unroll
            for (int i = 0; i < 16; ++i) ss += o1[mt][i] * o1[mt][i];
    }
    ss += __shfl_xor(ss, 32);
    const float rn = rsqrtf(ss * (1.f / 64.f) + RMS_EPS_) * outscale;
    bf16_t* orow = O + (tok0 + q0 + r) * 1024 + (TYPE ? 256 : 0) + hd * 64;
#pragma unroll
    for (int mt = 0; mt < 2; ++mt)
#pragma unroll
        for (int g4 = 0; g4 < 4; ++g4) {
            const int dv0 = 32 * mt + 8 * g4 + 4 * h;
            const f32x4 gg = *(const f32x4*)(normg + dv0);
            u32x2 w; w.x = pk2(o1[mt][4 * g4 + 0] * rn * gg[0], o1[mt][4 * g4 + 1] * rn * gg[1]); w.y = pk2(o1[mt][4 * g4 + 2] * rn * gg[2], o1[mt][4 * g4 + 3] * rn * gg[3]);
            *(u32x2*)(orow + dv0) = w;
        }
}

__device__ __forceinline__ void phase_attn(ArgsRef a, const Tb tb, int l, LAS unsigned char* lds) {
    unsigned char* ws = a.ws;
    const bf16_t* QK = (const bf16_t*)(ws + OFF_QK); const bf16_t* VT = (const bf16_t*)(ws + OFF_VT); bf16_t* O = (bf16_t*)(ws + OFF_O);
    const int lane = tb.tid & 63;
    const float lambda_init = 0.8f - 0.6f * expf(-0.3f * (float)l);
    const float* dl = a.in[12] + l * 128;
    float p01 = 0.f, p23 = 0.f;
    if (lane < 32) { p01 = dl[lane] * dl[32 + lane]; p23 = dl[64 + lane] * dl[96 + lane]; }
    p01 = wave_sum(p01); p23 = wave_sum(p23);
    const float lam = expf(p01) - expf(p23) + lambda_init;
    for (int u = tb.bid; u < 256; u += tb.G) {
        const int bh = (u & 7) + 8 * ((u >> 3) & 1), qb = u >> 4;
        attn_unit<0>(QK, VT, O, bh, qb, lam, a.in[13] + l * 64, 1.f - lambda_init, tb.tid, lds);
        attn_unit<1>(QK, VT, O, bh, 15 - qb, 0.f, a.in[14] + l * 64, 1.f, tb.tid, lds);
    }
}

constexpr int KB_LD = 136;
__device__ __forceinline__ void phase_dnprep(ArgsRef a, const Tb tb, int l, LAS unsigned char* lds) {
    unsigned char* ws = a.ws;
    const bf16_t* PC = (const bf16_t*)(ws + OFF_PC);
    const float* gates = (const float*)(ws + OFF_GATES);
    bf16_t* DW = (bf16_t*)(ws + OFF_DNW); bf16_t* DQG = (bf16_t*)(ws + OFF_DNQG); bf16_t* DKGT = (bf16_t*)(ws + OFF_DNKGT); bf16_t* DU = (bf16_t*)(ws + OFF_DNU); bf16_t* DA = (bf16_t*)(ws + OFF_DNA);
    float* EGL = (float*)(ws + OFF_EGL);
    const float* convw = a.in[8] + (size_t)l * 4 * 1536;
    LAS float* Lm = (LAS float*)lds;
    LAS float* gcs = Lm + 64 * 64;
    LAS float* betas = gcs + 64;
    LAS bf16_t* kb16 = (LAS bf16_t*)(betas + 64);
    LAS bf16_t* qb16 = kb16 + 64 * KB_LD;
    LAS float* rhs = (LAS float*)(qb16 + 64 * KB_LD);
    const int tid = tb.tid, wv = tid >> 6, lane = tid & 63;
    for (int ci = tb.bid; ci < 1024; ci += tb.G) {
        const int b = ci >> 8, h = (ci >> 6) & 3, n = ci & 63;
        const size_t t0 = (size_t)b * SEQ_ + n * 64;
        __syncthreads();
        if (wv == 0) {
            float g = gates[(t0 + lane) * 8 + h]; const float be = gates[(t0 + lane) * 8 + 4 + h];
#pragma unroll
            for (int o = 1; o < 64; o <<= 1) { const float t = __shfl_up(g, o); if (lane >= o) g += t; }
            gcs[lane] = g; betas[lane] = be;
            if (lane == 63) EGL[ci] = __expf(g);
        }
        __syncthreads();
        {
            const int row = tid >> 3, seg = tid & 7, cb = seg * 16;
            const float gci = gcs[row], bi = betas[row], eg = __expf(gci), egl = __expf(gcs[63] - gci);
            float val[3][16];
#pragma unroll
            for (int part = 0; part < 3; ++part) {
                const int col0 = part * 512 + h * 128 + cb;
#pragma unroll
                for (int c = 0; c < 16; ++c) val[part][c] = 0.f;
#pragma unroll
                for (int j = 0; j < 4; ++j) {
                    const int srow = n * 64 + row - 3 + j;
                    if (srow >= 0) {
                        const bf16_t* xp = PC + ((size_t)b * SEQ_ + srow) * 1536 + col0;
                        const u32x4 x0 = *(const u32x4*)xp, x1 = *(const u32x4*)(xp + 8);
                        const float* wp = convw + j * 1536 + col0;
#pragma unroll
                        for (int c4 = 0; c4 < 4; ++c4) {
                            const f32x4 w4 = *(const f32x4*)(wp + 4 * c4);
                            const unsigned xa = c4 < 2 ? x0[2 * c4] : x1[2 * (c4 - 2)], xb = c4 < 2 ? x0[2 * c4 + 1] : x1[2 * (c4 - 2) + 1];
                            val[part][4 * c4 + 0] += w4[0] * bflo(xa); val[part][4 * c4 + 1] += w4[1] * bfhi(xa);
                            val[part][4 * c4 + 2] += w4[2] * bflo(xb); val[part][4 * c4 + 3] += w4[3] * bfhi(xb);
                        }
                    }
                }
#pragma unroll
                for (int c = 0; c < 16; ++c) { const float x = val[part][c]; val[part][c] = x * __builtin_amdgcn_rcpf(1.f + __expf(-x)); }
            }
            float sq = 0.f, sk = 0.f;
#pragma unroll
            for (int c = 0; c < 16; ++c) { sq += val[0][c] * val[0][c]; sk += val[1][c] * val[1][c]; }
            sq += __shfl_xor(sq, 1); sq += __shfl_xor(sq, 2); sq += __shfl_xor(sq, 4);
            sk += __shfl_xor(sk, 1); sk += __shfl_xor(sk, 2); sk += __shfl_xor(sk, 4);
            const float rq = rsqrtf(sq + RMS_EPS_) * 0.08838834764831845f, rk = rsqrtf(sk + RMS_EPS_);
            unsigned qp[8], kp[8], qgp[8];
#pragma unroll
            for (int c = 0; c < 16; ++c) { val[0][c] *= rq; val[1][c] *= rk; }
#pragma unroll
            for (int c = 0; c < 8; ++c) { qp[c] = pk2(val[0][2 * c], val[0][2 * c + 1]); kp[c] = pk2(val[1][2 * c], val[1][2 * c + 1]); qgp[c] = pk2(val[0][2 * c] * eg, val[0][2 * c + 1] * eg); }
            *(LAS u32x4*)(qb16 + row * KB_LD + cb) = (u32x4){qp[0], qp[1], qp[2], qp[3]}; *(LAS u32x4*)(qb16 + row * KB_LD + cb + 8) = (u32x4){qp[4], qp[5], qp[6], qp[7]};
            *(LAS u32x4*)(kb16 + row * KB_LD + cb) = (u32x4){kp[0], kp[1], kp[2], kp[3]}; *(LAS u32x4*)(kb16 + row * KB_LD + cb + 8) = (u32x4){kp[4], kp[5], kp[6], kp[7]};
            bf16_t* qgd = DQG + ((size_t)ci * 64 + row) * 128 + (cb & ~31) + 4 * ((cb >> 4) & 1);
#pragma unroll
            for (int f = 0; f < 4; ++f) { u32x2 w2; w2.x = qgp[2 * f]; w2.y = qgp[2 * f + 1]; *(u32x2*)(qgd + 8 * f) = w2; }
#pragma unroll
            for (int c = 0; c < 16; ++c) {
                rhs[row * 256 + cb + c] = val[2][c] * bi;
                rhs[row * 256 + 128 + cb + c] = val[1][c] * bi * eg;
                const unsigned kg = pk2(val[1][c] * egl, 0.f);
                DKGT[((size_t)ci * 128 + cb + c) * 64 + (row & 32) + perm32k(row & 31)] = (bf16_t)(kg & 0xffff);
            }
        }
        __syncthreads();
        {
            const int mat = wv >> 2, ti = (wv >> 1) & 1, tj = wv & 1, r = lane & 31, hh = lane >> 5;
            f32x16 cacc;
#pragma unroll
            for (int i = 0; i < 16; ++i) cacc[i] = 0.f;
            if (tj <= ti) {
                LAS const bf16_t* ap = (mat ? qb16 : kb16) + (32 * ti + r) * KB_LD + 8 * hh;
                LAS const bf16_t* bp = kb16 + (32 * tj + r) * KB_LD + 8 * hh;
#pragma unroll
                for (int s = 0; s < 8; ++s) { const bf16x8 af = *(LAS const bf16x8*)(ap + 16 * s), bf = *(LAS const bf16x8*)(bp + 16 * s); cacc = MFMA32(af, bf, cacc); }
            }
            const int col = 32 * tj + r; const float gcol = gcs[col];
#pragma unroll
            for (int i = 0; i < 16; ++i) {
                const int row = 32 * ti + crow(i, hh);
                const float dec = (row >= col) ? __expf(gcs[row] - gcol) : 0.f;
                if (mat == 0) Lm[row * 64 + col] = (col < row) ? betas[row] * cacc[i] * dec : 0.f;
                else { const unsigned av = pk2((col <= row) ? cacc[i] * dec : 0.f, 0.f); DA[((size_t)ci * 64 + row) * 64 + (col & 32) + perm32k(col & 31)] = (bf16_t)(av & 0xffff); }
            }
        }
        __syncthreads();
        if (tid < 256) {
            const int col = tid;
            float acc[64];
#pragma unroll
            for (int i = 0; i < 64; ++i) acc[i] = rhs[i * 256 + col];
#pragma unroll
            for (int jp = 0; jp < 16; ++jp) {
                const int r0 = 4 * jp;
                const f32x4 d1 = *(LAS const f32x4*)(Lm + (r0 + 1) * 64 + r0), d2 = *(LAS const f32x4*)(Lm + (r0 + 2) * 64 + r0), d3 = *(LAS const f32x4*)(Lm + (r0 + 3) * 64 + r0);
                const float x0 = acc[r0];
                const float x1 = acc[r0 + 1] - d1[0] * x0;
                const float x2 = (acc[r0 + 2] - d2[0] * x0) - d2[1] * x1;
                const float x3 = ((acc[r0 + 3] - d3[0] * x0) - d3[1] * x1) - d3[2] * x2;
                rhs[(r0 + 0) * 256 + col] = x0; rhs[(r0 + 1) * 256 + col] = x1; rhs[(r0 + 2) * 256 + col] = x2; rhs[(r0 + 3) * 256 + col] = x3;
#pragma unroll
                for (int i = r0 + 4; i < 64; ++i) {
                    const f32x4 l4 = *(LAS const f32x4*)(Lm + i * 64 + r0);
                    acc[i] = (((acc[i] - l4[0] * x0) - l4[1] * x1) - l4[2] * x2) - l4[3] * x3;
                }
            }
        }
        __syncthreads();
        {
            const int row = tid >> 3, cb = (tid & 7) * 16;
            LAS const float* xp = rhs + row * 256 + 128 + cb;
            unsigned p[8];
#pragma unroll
            for (int c = 0; c < 8; ++c) p[c] = pk2(xp[2 * c], xp[2 * c + 1]);
            bf16_t* wd = DW + ((size_t)ci * 64 + row) * 128 + (cb & ~31) + 4 * ((cb >> 4) & 1);
#pragma unroll
            for (int f = 0; f < 4; ++f) { u32x2 w2; w2.x = p[2 * f]; w2.y = p[2 * f + 1]; *(u32x2*)(wd + 8 * f) = w2; }
            const int slice = tid >> 6, lp = tid & 63, fq = lp >> 4, fr = lp & 15;
            LAS const float* up = rhs + (4 * fq) * 256 + slice * 16 + fr;
            unsigned q[8];
#pragma unroll
            for (int e = 0; e < 8; ++e) { const int t = e >> 1, rg = (e & 1) * 2; q[e] = pk2(up[(16 * t + rg) * 256], up[(16 * t + rg + 1) * 256]); }
            bf16_t* ud = DU + (((size_t)ci * 8 + slice) * 64 + lp) * 16;
            *(u32x4*)ud = (u32x4){q[0], q[1], q[2], q[3]}; *(u32x4*)(ud + 8) = (u32x4){q[4], q[5], q[6], q[7]};
        }
    }
    __syncthreads();
}

constexpr int SC_W = 0, SC_QG = 64 * 272, SC_A = 2 * 64 * 272, SC_KGT = SC_A + 64 * 144, SC_U = SC_KGT + 128 * 144, SC_BUF = SC_U + 2048, SC_EG = 2 * SC_BUF;
static_assert(SC_EG + 256 <= 131072, "scan LDS");
__device__ __forceinline__ bf16x8 lds8(LAS const unsigned char* p) { return *(LAS const bf16x8*)p; }
__device__ __forceinline__ void phase_dnscan(ArgsRef a, const Tb tb, LAS unsigned char* lds) {
    if (tb.bid >= 128) return;
    unsigned char* ws = a.ws;
    const unsigned char* DW = ws + OFF_DNW; const unsigned char* DQG = ws + OFF_DNQG; const unsigned char* DKGT = ws + OFF_DNKGT; const unsigned char* DA = ws + OFF_DNA;
    const bf16_t* DU = (const bf16_t*)(ws + OFF_DNU);
    const float* EGL = (const float*)(ws + OFF_EGL);
    float* OC = (float*)(ws + OFF_OCRAW);
    const int tid = tb.tid, wv = tid >> 6, lane = tid & 63;
    const int bh = (tb.bid & 7) + 8 * ((tb.bid >> 3) & 1), slice = tb.bid >> 4, b = bh >> 2, h = bh & 3;
    unsigned goff[8], loff[8]; int garr[8];
    const int lt = tid - 64;
#pragma unroll
    for (int i = 0; i < 8; ++i) {
        const int p = lt + 448 * i;
        int arr, q;
        if (p < 1024) { arr = 0; q = p; } else if (p < 2048) { arr = 1; q = p - 1024; } else if (p < 2560) { arr = 2; q = p - 2048; } else { arr = 3; q = p - 2560; }
        garr[i] = arr; goff[i] = (unsigned)q * 16u;
        if (arr < 2) loff[i] = (unsigned)((arr ? SC_QG : SC_W) + (q >> 4) * 272 + (q & 15) * 16);
        else loff[i] = (unsigned)((arr == 2 ? SC_A : SC_KGT) + (q >> 3) * 144 + (q & 7) * 16);
    }
    auto load_chunk = [&](int ci, u32x4 (&v)[9]) {
#pragma unroll
        for (int i = 0; i < 8; ++i) {
            const unsigned char* base = garr[i] == 0 ? DW + (size_t)ci * 16384 : garr[i] == 1 ? DQG + (size_t)ci * 16384 : garr[i] == 2 ? DA + (size_t)ci * 8192 : DKGT + (size_t)ci * 16384;
            v[i] = *(const u32x4*)(base + goff[i]);
        }
        if (lt < 128) v[8] = *(const u32x4*)((const unsigned char*)DU + ((size_t)ci * 8 + slice) * 2048 + lt * 16);
    };
    auto store_chunk = [&](int buf, const u32x4 (&v)[9]) {
#pragma unroll
        for (int i = 0; i < 8; ++i) *(LAS u32x4*)(lds + buf * SC_BUF + loff[i]) = v[i];
        if (lt < 128) *(LAS u32x4*)(lds + buf * SC_BUF + SC_U + lt * 16) = v[8];
    };
#define SC_BARRIER() do { asm volatile("s_waitcnt lgkmcnt(0)" ::: "memory"); __builtin_amdgcn_s_barrier(); asm volatile("" ::: "memory"); } while (0)
    if (wv > 0) {
        u32x4 l0[9], l1[9], l2[9];
        const int c0 = bh * 64;
        if (lt < 64) *(LAS float*)(lds + SC_EG + lt * 4) = EGL[c0 + lt];
        load_chunk(c0, l0); store_chunk(0, l0);
        load_chunk(c0 + 1, l0); load_chunk(c0 + 2, l1); load_chunk(c0 + 3, l2);
        SC_BARRIER();
#define SC_LSTEP(nn, L) do { if ((nn) + 1 < 64) store_chunk(((nn) + 1) & 1, L); if ((nn) + 4 < 64) load_chunk(c0 + (nn) + 4, L); SC_BARRIER(); } while (0)
        for (int n = 0; n < 63; n += 3) { SC_LSTEP(n, l0); SC_LSTEP(n + 1, l1); SC_LSTEP(n + 2, l2); }
        SC_LSTEP(63, l0);
#undef SC_LSTEP
        return;
    }
    SC_BARRIER();
    const int fr = lane & 15, fq = lane >> 4;
    f32x4 S[8];
#pragma unroll
    for (int t = 0; t < 8; ++t) S[t] = (f32x4){0.f, 0.f, 0.f, 0.f};
    for (int n = 0; n < 64; ++n) {
        const int ci = bh * 64 + n;
        {
            LAS const unsigned char* L = lds + (n & 1) * SC_BUF;
            LAS const unsigned char* wp = L + SC_W + fr * 272 + fq * 16;
            LAS const unsigned char* qp = L + SC_QG + fr * 272 + fq * 16;
            LAS const unsigned char* ap = L + SC_A + fr * 144 + fq * 16;
            LAS const unsigned char* kp = L + SC_KGT + fr * 144 + fq * 16;
            const float eg = *(LAS const float*)(lds + SC_EG + n * 4);
            u32x4 un[2]; un[0] = *(LAS const u32x4*)(L + SC_U + lane * 32); un[1] = *(LAS const u32x4*)(L + SC_U + lane * 32 + 16);
            bf16x8 sb[4];
#pragma unroll
            for (int kt = 0; kt < 4; ++kt) { u32x4 pk; pk[0] = pk2(S[2 * kt][0], S[2 * kt][1]); pk[1] = pk2(S[2 * kt][2], S[2 * kt][3]); pk[2] = pk2(S[2 * kt + 1][0], S[2 * kt + 1][1]); pk[3] = pk2(S[2 * kt + 1][2], S[2 * kt + 1][3]); sb[kt] = __builtin_bit_cast(bf16x8, pk); }
            f32x4 vn[4], ot[4];
#pragma unroll
            for (int t = 0; t < 4; ++t) { vn[t] = (f32x4){0.f, 0.f, 0.f, 0.f}; ot[t] = (f32x4){0.f, 0.f, 0.f, 0.f}; }
            bf16x8 vb[2];
            bf16x8 fr12[12];
#define SC_FRAG(i) ((i) < 16 ? lds8(wp + ((i) >> 2) * 16 * 272 + ((i) & 3) * 64) \
                  : (i) < 32 ? lds8(qp + (((i) - 16) >> 2) * 16 * 272 + (((i) - 16) & 3) * 64) \
                  : (i) < 40 ? lds8(ap + (((i) - 32) >> 1) * 16 * 144 + (((i) - 32) & 1) * 64) \
                  :            lds8(kp + (((i) - 40) >> 1) * 16 * 144 + (((i) - 40) & 1) * 64))
#pragma unroll
            for (int i = 0; i < 8; ++i) fr12[i] = SC_FRAG(i);
            __builtin_amdgcn_sched_barrier(0);
#pragma unroll
            for (int g = 0; g < 14; ++g) {
                if (g + 2 < 14) {
#pragma unroll
                    for (int j = 0; j < 4; ++j) fr12[((g + 2) % 3) * 4 + j] = SC_FRAG(4 * (g + 2) + j);
                }
#pragma unroll
                for (int j = 0; j < 4; ++j) {
                    const int i = 4 * g + j; const bf16x8 f = fr12[(g % 3) * 4 + j];
                    if (i < 16) vn[i >> 2] = MFMA16(f, sb[i & 3], vn[i >> 2]);
                    else if (i < 32) ot[(i - 16) >> 2] = MFMA16(f, sb[(i - 16) & 3], ot[(i - 16) >> 2]);
                    else if (i < 40) ot[(i - 32) >> 1] = MFMA16(f, vb[(i - 32) & 1], ot[(i - 32) >> 1]);
                    else S[(i - 40) >> 1] = MFMA16(f, vb[(i - 40) & 1], S[(i - 40) >> 1]);
                }
                if (g == 1 || g == 3) {
                    const int ks = g >> 1; const u32x4 uu = un[ks];
                    f32x4 va, vbb;
                    va[0] = bflo(uu[0]) - vn[2 * ks][0]; va[1] = bfhi(uu[0]) - vn[2 * ks][1]; va[2] = bflo(uu[1]) - vn[2 * ks][2]; va[3] = bfhi(uu[1]) - vn[2 * ks][3];
                    vbb[0] = bflo(uu[2]) - vn[2 * ks + 1][0]; vbb[1] = bfhi(uu[2]) - vn[2 * ks + 1][1]; vbb[2] = bflo(uu[3]) - vn[2 * ks + 1][2]; vbb[3] = bfhi(uu[3]) - vn[2 * ks + 1][3];
                    u32x4 pk; pk[0] = pk2(va[0], va[1]); pk[1] = pk2(va[2], va[3]); pk[2] = pk2(vbb[0], vbb[1]); pk[3] = pk2(vbb[2], vbb[3]);
                    vb[ks] = __builtin_bit_cast(bf16x8, pk);
                }
                if (g >= 4 && g < 8) { S[2 * (g - 4)] *= eg; S[2 * (g - 4) + 1] *= eg; }
                __builtin_amdgcn_sched_barrier(0);
            }
#undef SC_FRAG
            float* op = OC + ((size_t)b * SEQ_ + n * 64 + 4 * fq) * 512 + h * 128 + slice * 16 + fr;
#pragma unroll
            for (int t = 0; t < 4; ++t)
#pragma unroll
                for (int rg = 0; rg < 4; ++rg) op[(size_t)(16 * t + rg) * 512] = ot[t][rg];
        }
        SC_BARRIER();
    }
#undef SC_BARRIER
}

__device__ __forceinline__ void phase_dnout(ArgsRef a, const Tb tb, int l) {
    unsigned char* ws = a.ws;
    const float* OC = (const float*)(ws + OFF_OCRAW); const bf16_t* Z = (const bf16_t*)(ws + OFF_Z); bf16_t* O = (bf16_t*)(ws + OFF_O);
    const float* g = a.in[11] + l * 128;
    const int wv = tb.tid >> 6, lane = tb.tid & 63, sub = lane >> 4, l16 = lane & 15;
    const int gw = tb.bid * 8 + wv, GW = tb.G * 8;
    const f32x4 g0 = *(const f32x4*)(g + l16 * 8), g1 = *(const f32x4*)(g + l16 * 8 + 4);
    for (int u = gw * 4 + sub; u < T_ * 4; u += GW * 4) {
        const int t = u >> 2, h = u & 3;
        const float* op = OC + (size_t)t * 512 + h * 128 + l16 * 8;
        const f32x4 v0 = *(const f32x4*)op, v1 = *(const f32x4*)(op + 4);
        const u32x4 zz = *(const u32x4*)(Z + (size_t)t * 512 + h * 128 + l16 * 8);
        float ss = (v0[0] * v0[0] + v0[1] * v0[1]) + (v0[2] * v0[2] + v0[3] * v0[3]) + (v1[0] * v1[0] + v1[1] * v1[1]) + (v1[2] * v1[2] + v1[3] * v1[3]);
        ss += __shfl_xor(ss, 8); ss += __shfl_xor(ss, 4); ss += __shfl_xor(ss, 2); ss += __shfl_xor(ss, 1);
        const float rn = rsqrtf(ss * (1.f / 128.f) + RMS_EPS_);
        float o[8];
#pragma unroll
        for (int i = 0; i < 4; ++i) {
            const float za = bflo(zz[i]), zb = bfhi(zz[i]);
            const float va = i < 2 ? v0[2 * i] : v1[2 * i - 4], vb = i < 2 ? v0[2 * i + 1] : v1[2 * i - 3];
            const float ga = i < 2 ? g0[2 * i] : g1[2 * i - 4], gb = i < 2 ? g0[2 * i + 1] : g1[2 * i - 3];
            o[2 * i] = va * rn * ga * (za * __builtin_amdgcn_rcpf(1.f + __expf(-za)));
            o[2 * i + 1] = vb * rn * gb * (zb * __builtin_amdgcn_rcpf(1.f + __expf(-zb)));
        }
        u32x4 w; w[0] = pk2(o[0], o[1]); w[1] = pk2(o[2], o[3]); w[2] = pk2(o[4], o[5]); w[3] = pk2(o[6], o[7]);
        *(u32x4*)(O + (size_t)t * 1024 + 512 + h * 128 + l16 * 8) = w;
    }
}

__device__ __forceinline__ void phase_final(ArgsRef a, const Tb tb) {
    const float* part = (const float*)(a.ws + OFF_STATS) + (size_t)5 * T_ * 32;
    const float* g = a.in[5] + 5 * D_; const float* bb = a.in[6] + 5 * D_;
    const int wv = tb.tid >> 6, lane = tb.tid & 63;
    const int gw = tb.bid * 8 + wv, GW = tb.G * 8;
    for (int t = gw; t < T_; t += GW) {
        float s = 0.f, q = 0.f;
        if (lane < 8) { const f32x4 v = *(const f32x4*)(part + (size_t)t * 32 + lane * 4); s = v[0] + v[2]; q = v[1] + v[3]; }
        s = wave_sum(s); q = wave_sum(q);
        const float mu = s * (1.f / 1024.f), rstd = rsqrtf(fmaxf(q * (1.f / 1024.f) - mu * mu, 0.f) + LN_EPS_);
#pragma unroll
        for (int i = 0; i < 4; ++i) {
            const int col = i * 256 + lane * 4;
            const u32x2 rb = *(const u32x2*)((const bf16_t*)(a.ws + OFF_YB) + (size_t)t * D_ + col);
            f32x4 y = (f32x4){bflo(rb.x), bfhi(rb.x), bflo(rb.y), bfhi(rb.y)};
            const f32x4 g4 = *(const f32x4*)(g + col), b4 = *(const f32x4*)(bb + col);
            y = (y - mu) * rstd * g4 + b4;
            *(f32x4*)(a.out + (size_t)t * D_ + col) = y;
        }
    }
}

#define XB_TMO      128
#define XB_XCNT(j)  (256  + 64 * (j))
#define XB_XSUB(j)  (1280 + 64 * (j))
#define XB_XGEN(j)  (2304 + 64 * (j))
#define XB_TOP      3328
#define XB_TOPGEN   3392
#define XCD_BAR_WORDS 3456
#define XB_SPIN_CAP (1u << 18)

__device__ __forceinline__ unsigned xb_ld(unsigned* p)              { return __hip_atomic_load(p, __ATOMIC_RELAXED, __HIP_MEMORY_SCOPE_AGENT); }
__device__ __forceinline__ unsigned xb_add(unsigned* p, unsigned v) { return __hip_atomic_fetch_add(p, v, __ATOMIC_RELAXED, __HIP_MEMORY_SCOPE_AGENT); }
__device__ __forceinline__ unsigned xb_xcc_id() { return (unsigned)__builtin_amdgcn_s_getreg((3 << 11) | 20) & 0xFu; }
#define XB_SPIN(cond, bar) do { unsigned _sp = 0; while (cond) { __builtin_amdgcn_s_sleep(1); \
    if ((++_sp & 255u) == 0u) { if (xb_ld(&(bar)[XB_TMO])) break; if (_sp > XB_SPIN_CAP) { atomicAdd(&(bar)[XB_TMO], 1u); break; } } } } while (0)

struct XcdBarrier {
    unsigned* bar; unsigned x;
    volatile LAS unsigned* st;
};

__device__ __forceinline__ XcdBarrier xcd_barrier_post(unsigned* bar, volatile LAS unsigned* st) {
    XcdBarrier b; b.bar = bar; b.x = xb_xcc_id(); b.st = st;
    if (threadIdx.x == 0) (void)xb_add(&bar[XB_XCNT(b.x)], 1u);
    return b;
}
__device__ __forceinline__ void xcd_barrier_complete(unsigned* bar, unsigned x, unsigned& nloc, unsigned& nx) {
    const unsigned G = gridDim.x * gridDim.y * gridDim.z;
    unsigned sum, cnt, mine, sp = 0u;
    for (;;) {
        sum = 0u; cnt = 0u; mine = 0u;
#pragma unroll
        for (unsigned j = 0; j < 16; ++j) { const unsigned c = xb_ld(&bar[XB_XCNT(j)]); sum += c; cnt += (c > 0u) ? 1u : 0u; mine = (j == x) ? c : mine; }
        if (sum == G) break;
        __builtin_amdgcn_s_sleep(1);
        if ((++sp & 255u) == 0u) { if (xb_ld(&bar[XB_TMO])) break; if (sp > XB_SPIN_CAP) { atomicAdd(&bar[XB_TMO], 1u); break; } }
    }
    nloc = mine > 0u ? mine : 1u; nx = cnt > 0u ? cnt : 1u;
}

__device__ __forceinline__ void xcd_barrier(const XcdBarrier& b) {
    asm volatile("s_waitcnt vmcnt(0)" ::: "memory");
    __syncthreads();
    if (threadIdx.x == 0) {
        unsigned* bar = b.bar;
        __builtin_amdgcn_s_waitcnt(0);
        unsigned nloc = b.st[0], nx = b.st[1];
        if (nloc == 0u) { xcd_barrier_complete(bar, b.x, nloc, nx); b.st[0] = nloc; b.st[1] = nx; }
        const unsigned old = xb_add(&bar[XB_XSUB(b.x)], 1u);
        const unsigned gen = old / nloc;
        if (old + 1u == (gen + 1u) * nloc) {
            __builtin_amdgcn_fence(__ATOMIC_RELEASE, "agent");
            asm volatile("s_waitcnt vmcnt(0)" ::: "memory");
            const unsigned og = xb_add(&bar[XB_TOP], 1u);
            const unsigned tg = og / nx;
            if (og + 1u == (tg + 1u) * nx) xb_add(&bar[XB_TOPGEN], 1u);
            else XB_SPIN(xb_ld(&bar[XB_TOPGEN]) == tg, bar);
            __builtin_amdgcn_fence(__ATOMIC_ACQUIRE, "agent");
            xb_add(&bar[XB_XGEN(b.x)], 1u);
            asm volatile("s_waitcnt vmcnt(0)" ::: "memory");
        } else {
            XB_SPIN(xb_ld(&bar[XB_XGEN(b.x)]) == gen, bar);
            __builtin_amdgcn_fence(__ATOMIC_ACQUIRE, "agent");
            asm volatile("s_waitcnt vmcnt(0)" ::: "memory");
        }
    }
    __syncthreads();
}


#ifdef ONLY
#define PH_ENABLED(n) ((n) == ONLY)
#else
#define PH_ENABLED(n) true
#endif
constexpr int PH_PER_LAYER = 14, N_PHASES = 2 * PH_PER_LAYER + 1;
__device__ __forceinline__ void run_phase(int ph, LAS unsigned char* lds) {
    const __attribute__((address_space(4))) Args* ap = (const __attribute__((address_space(4))) Args*)__builtin_amdgcn_kernarg_segment_ptr();
    asm volatile("" : "+s"(ap));
    ArgsRef a = *ap;
    Tb tb; tb.tid = threadIdx.x; tb.bid = blockIdx.x; tb.G = gridDim.x;
    asm volatile("" : "+v"(tb.tid)); asm volatile("" : "+s"(tb.bid)); asm volatile("" : "+s"(tb.G));
    unsigned char* ws = a.ws;
    if (ph == N_PHASES - 1) { if (PH_ENABLED(99)) phase_final(a, tb); return; }
    const int l = ph / PH_PER_LAYER, p = ph % PH_PER_LAYER;
    float* stats = (float*)(ws + OFF_STATS);
    const float* mur = (const float*)(ws + OFF_MUR);
    const float* mu_in = l > 0 ? mur + (size_t)((l - 1) * 3 + 2) * T_ * 2 : nullptr;
    const float* mu0 = mur + (size_t)(l * 3 + 0) * T_ * 2; const float* mu1 = mur + (size_t)(l * 3 + 1) * T_ * 2;
    float* st0 = stats + (size_t)(l * 3 + 0) * T_ * 32; float* st1 = stats + (size_t)(l * 3 + 1) * T_ * 32; float* st2 = stats + (size_t)(l * 3 + 2) * T_ * 32;
    const float* ln_g = a.in[5]; const float* ln_b = a.in[6];
    pg8::StaticOrder S;
    switch (p) {
    case 0: if (PH_ENABLED(0)) { if (l == 0) pro_part(a, tb, 0, 0, tb.bid, tb.G, lds); } break;
    case 1: if (PH_ENABLED(1)) { pg8::Gemm g{(const bf16_t*)(ws + OFF_YB), (const bf16_t*)(ws + OFF_WGU0), T_, 2 * FF_, D_}; S.init(g.M, g.N, tb.G, tb.bid);
        EpiGU E{(bf16_t*)(ws + OFF_H), mu_in, (const float*)(ws + OFF_C12GU0), (const float*)(ws + OFF_C12GU0) + 5632}; pg8::gemm_phase(tb, lds, g, S, E); } break;
    case 2: if (PH_ENABLED(2)) { pg8::Gemm g{(const bf16_t*)(ws + OFF_H), (const bf16_t*)(ws + OFF_WDN0), T_, D_, FF_}; S.init(g.M, g.N, tb.G, tb.bid);
        EpiRes E{nullptr, (bf16_t*)(ws + OFF_YB), mu_in, l > 0 ? ln_g + ((l - 1) * 3 + 2) * D_ : nullptr, l > 0 ? ln_b + ((l - 1) * 3 + 2) * D_ : nullptr, st0, 0.5f}; pg8::gemm_phase(tb, lds, g, S, E); } break;
    case 3: if (PH_ENABLED(3)) phase_statsfin(a, tb, l * 3 + 0); break;
    case 4: if (PH_ENABLED(4)) { pg8::Gemm g{(const bf16_t*)(ws + OFF_YB), (const bf16_t*)(ws + OFF_WIN), T_, NING_, D_}; S.init(g.M, g.N, tb.G, tb.bid);
        EpiIn E{mu0, (const float*)(ws + OFF_C12IN), (const float*)(ws + OFF_C12IN) + 3584, (bf16_t*)(ws + OFF_QK), (bf16_t*)(ws + OFF_VT), (bf16_t*)(ws + OFF_PC), (bf16_t*)(ws + OFF_Z)}; pg8::gemm_phase(tb, lds, g, S, E);
        } break;
    case 5: if (PH_ENABLED(5)) { phase_gates(a, tb, l); phase_attn(a, tb, l, lds); } break;
    case 6: if (PH_ENABLED(6)) phase_dnprep(a, tb, l, lds); break;
    case 7: if (PH_ENABLED(7)) { phase_dnscan(a, tb, lds);
        if (tb.bid >= 128) { pro_part(a, tb, l, 1, tb.bid - 128, tb.G - 128, lds); if (l == 0) pro_part(a, tb, 1, 0, tb.bid - 128, tb.G - 128, lds); } } break;
    case 8: if (PH_ENABLED(8)) phase_dnout(a, tb, l); break;
    case 9: if (PH_ENABLED(9)) { pg8::Gemm g{(const bf16_t*)(ws + OFF_O), (const bf16_t*)(ws + OFF_WOUT), T_, D_, D_}; S.init(g.M, g.N, tb.G, tb.bid);
        EpiRes E{nullptr, (bf16_t*)(ws + OFF_YB), mu0, ln_g + (l * 3 + 0) * D_, ln_b + (l * 3 + 0) * D_, st1, 1.0f}; pg8::gemm_phase(tb, lds, g, S, E); } break;
    case 10: if (PH_ENABLED(10)) phase_statsfin(a, tb, l * 3 + 1); break;
    case 11: if (PH_ENABLED(11)) { pg8::Gemm g{(const bf16_t*)(ws + OFF_YB), (const bf16_t*)(ws + OFF_WGU1), T_, 2 * FF_, D_}; S.init(g.M, g.N, tb.G, tb.bid);
        EpiGU E{(bf16_t*)(ws + OFF_H), mu1, (const float*)(ws + OFF_C12GU1), (const float*)(ws + OFF_C12GU1) + 5632}; pg8::gemm_phase(tb, lds, g, S, E); } break;
    case 12: if (PH_ENABLED(12)) { pg8::Gemm g{(const bf16_t*)(ws + OFF_H), (const bf16_t*)(ws + OFF_WDN1), T_, D_, FF_}; S.init(g.M, g.N, tb.G, tb.bid);
        EpiRes E{nullptr, (bf16_t*)(ws + OFF_YB), mu1, ln_g + (l * 3 + 1) * D_, ln_b + (l * 3 + 1) * D_, st2, 0.5f}; pg8::gemm_phase(tb, lds, g, S, E); } break;
    case 13: if (PH_ENABLED(13)) phase_statsfin(a, tb, l * 3 + 2); break;
    }
}

__global__ void __launch_bounds__(512, 2) mk_fwd(Args a) {
    extern __shared__ __attribute__((aligned(16))) unsigned char shm[];
    LAS unsigned char* lds = (LAS unsigned char*)shm;
#if MULTI_LAUNCH
    run_phase(a.ph_lo, lds);
#else
    cg::grid_group grid = cg::this_grid();
    volatile LAS unsigned* st = (volatile LAS unsigned*)(lds + 131072);
    if (threadIdx.x == 0) { st[0] = 0u; st[1] = 0u; }
    __syncthreads();
    const XcdBarrier xb = xcd_barrier_post((unsigned*)(a.ws + OFF_BAR), st);
    if (a.ph_hi < 0) grid.sync();
    for (int ph = a.ph_lo; ph < a.ph_hi; ++ph) {
        if (ph == PH_PER_LAYER || ph == 2 * PH_PER_LAYER - 1) continue;
        run_phase(ph, lds);
        if (ph + 1 < a.ph_hi) xcd_barrier(xb);
    }
#endif
}

extern "C" void kernel_launch(void* const* d_in, const int* in_sizes, int n_in, void* d_out, int out_size, void* d_ws, size_t ws_size, hipStream_t stream) {
    static int grid = 0;
    if (grid == 0) {
        if (n_in != 16 || out_size != T_ * D_ || ws_size < WS_END) { fprintf(stderr, "kernel_launch: unexpected shapes (n_in %d out %d ws %zu need %zu)\n", n_in, out_size, ws_size, (size_t)WS_END); grid = -1; return; }
        int dev = 0, cus = 0, per_cu = 0;
        hipGetDevice(&dev);
        hipDeviceGetAttribute(&cus, hipDeviceAttributeMultiprocessorCount, dev);
        if (hipFuncSetAttribute((const void*)mk_fwd, hipFuncAttributeMaxDynamicSharedMemorySize, LDS_BYTES) != hipSuccess) { fprintf(stderr, "kernel_launch: hipFuncSetAttribute failed\n"); grid = -1; return; }
        hipOccupancyMaxActiveBlocksPerMultiprocessor(&per_cu, (const void*)mk_fwd, 512, LDS_BYTES);
        (void)hipGetLastError();
        if (per_cu < 1) per_cu = 1;
        grid = cus * 1;
        fprintf(stderr, "kernel_launch: cus %d per_cu %d grid %d\n", cus, per_cu, grid);
    }
    if (grid < 0) return;
    Args a{};
    for (int i = 0; i < 16; ++i) a.in[i] = (const float*)d_in[i];
    a.out = (float*)d_out; a.ws = (unsigned char*)d_ws;
#if MULTI_LAUNCH
    for (int ph = 0; ph < N_PHASES; ++ph) {
        a.ph_lo = ph; a.ph_hi = ph + 1;
        hipLaunchKernelGGL(mk_fwd, dim3(grid), dim3(512), LDS_BYTES, stream, a);
    }
#else
    a.ph_lo = 0; a.ph_hi = N_PHASES;
    if (hipMemsetAsync((unsigned char*)d_ws + OFF_BAR, 0, BAR_BYTES, stream) != hipSuccess) { fprintf(stderr, "kernel_launch: memset of the barrier words failed\n"); return; }
    void* args[] = {&a};
    hipError_t e = hipLaunchCooperativeKernel((const void*)mk_fwd, dim3(grid), dim3(512), args, LDS_BYTES, stream);
    if (e != hipSuccess) fprintf(stderr, "cooperative launch failed: %s (grid %d)\n", hipGetErrorString(e), grid);
#endif
}
```

```cpp
#include <hip/hip_runtime.h>
#include <hip/hip_cooperative_groups.h>
#include <cstdio>
#include <cstdint>
namespace cg = cooperative_groups;

#ifndef MULTI_LAUNCH
#define MULTI_LAUNCH 0
#endif

#define LAS __attribute__((address_space(3)))
typedef unsigned short bf16_t;
typedef short bf16x8 __attribute__((ext_vector_type(8)));
typedef float f32x4 __attribute__((ext_vector_type(4)));
typedef float f32x16 __attribute__((ext_vector_type(16)));
typedef unsigned u32x4 __attribute__((ext_vector_type(4)));
typedef unsigned u32x2 __attribute__((ext_vector_type(2)));

constexpr int T_ = 16384, D_ = 1024, FF_ = 2816, NIN_ = 3592, NING_ = 3584, SEQ_ = 4096;
constexpr float ALPHA_ = 1.4142135623730951f;
constexpr float LN_EPS_ = 1e-5f, RMS_EPS_ = 1e-6f;
constexpr int LDS_BYTES = 131072 + 16;

constexpr size_t SZ_WGU = (size_t)2 * FF_ * D_ * 2;
constexpr size_t SZ_WDN = (size_t)D_ * FF_ * 2;
constexpr size_t SZ_WIN = (size_t)NING_ * D_ * 2;
constexpr size_t SZ_WOUT = (size_t)D_ * D_ * 2;
constexpr size_t OFF_WGU0 = 0;
constexpr size_t OFF_WGU1 = OFF_WGU0 + SZ_WGU;
constexpr size_t OFF_WDN0 = OFF_WGU1 + SZ_WGU;
constexpr size_t OFF_WDN1 = OFF_WDN0 + SZ_WDN;
constexpr size_t OFF_WIN = OFF_WDN1 + SZ_WDN;
constexpr size_t OFF_WOUT = OFF_WIN + SZ_WIN;
constexpr size_t OFF_C12GU0 = OFF_WOUT + SZ_WOUT;
constexpr size_t OFF_C12GU1 = OFF_C12GU0 + (size_t)2 * 5632 * 4;
constexpr size_t OFF_C12IN = OFF_C12GU1 + (size_t)2 * 5632 * 4;
constexpr size_t OFF_WG8 = OFF_C12IN + (size_t)2 * 3584 * 4;
constexpr size_t OFF_STATS = OFF_WG8 + (size_t)(8 * 1024 + 16) * 4;
constexpr size_t OFF_MUR = OFF_STATS + (size_t)6 * T_ * 32 * 4;
constexpr size_t OFF_GATES = OFF_MUR + (size_t)6 * T_ * 2 * 4;
constexpr size_t OFF_EGL = OFF_GATES + (size_t)T_ * 8 * 4;
constexpr size_t OFF_BAR = ((OFF_EGL + 4096 + 255) / 256) * 256;
constexpr size_t BAR_BYTES = 16384;
constexpr size_t OFF_YB = OFF_BAR + BAR_BYTES;
constexpr size_t OFF_R1 = OFF_YB + (size_t)T_ * D_ * 2;
constexpr size_t OFF_H = OFF_R1;
constexpr size_t OFF_QK = OFF_R1;
constexpr size_t OFF_VT = OFF_QK + (size_t)T_ * 1024 * 2;
constexpr size_t OFF_DNW = OFF_R1;
constexpr size_t SZ_DN16 = (size_t)1024 * 64 * 128 * 2;
constexpr size_t OFF_DNQG = OFF_DNW + SZ_DN16;
constexpr size_t OFF_DNKGT = OFF_DNQG + SZ_DN16;
constexpr size_t OFF_DNU = OFF_DNKGT + SZ_DN16;
constexpr size_t OFF_DNA = OFF_DNU + SZ_DN16;
constexpr size_t OFF_PC = OFF_DNA + (size_t)1024 * 64 * 64 * 2;
constexpr size_t OFF_OCRAW = OFF_PC;
constexpr size_t OFF_Z = OFF_PC + (size_t)T_ * 1536 * 2;
constexpr size_t OFF_O = OFF_Z + (size_t)T_ * 512 * 2;
constexpr size_t WS_END = OFF_O + (size_t)T_ * 1024 * 2;
static_assert(OFF_VT + (size_t)2 * 16 * 64 * 4096 * 2 <= OFF_PC, "VT overlaps PC");
static_assert(OFF_H + (size_t)T_ * FF_ * 2 <= WS_END, "h fits");
static_assert(WS_END <= (size_t)268435456, "workspace");

struct Args {
    const float* in[16];
    float* out;
    unsigned char* ws;
    int ph_lo, ph_hi;
};

typedef const __attribute__((address_space(4))) Args& ArgsRef;
struct Tb { int tid, bid, G; };

typedef float f32x2_t __attribute__((ext_vector_type(2)));
typedef __bf16 bf16x2_t __attribute__((ext_vector_type(2)));
__device__ __forceinline__ unsigned pk2(float lo, float hi) { const f32x2_t v = {lo, hi}; const bf16x2_t b = __builtin_convertvector(v, bf16x2_t); return __builtin_bit_cast(unsigned, b); }
__device__ __forceinline__ float bf2f(unsigned b) { return __uint_as_float(b << 16); }
__device__ __forceinline__ float bflo(unsigned w) { return __uint_as_float(w << 16); }
__device__ __forceinline__ float bfhi(unsigned w) { return __uint_as_float(w & 0xffff0000u); }
__device__ __forceinline__ int swap23(int x) { return (x & ~12) | ((x & 4) << 1) | ((x & 8) >> 1); }
__device__ __forceinline__ int crow(int reg, int h) { return (reg & 3) + 8 * (reg >> 2) + 4 * h; }
__device__ __forceinline__ int perm32k(int q) { return ((q >> 2) & 3) * 8 + ((q >> 4) & 1) * 4 + (q & 3); }
#define MFMA16(a, b, c) __builtin_amdgcn_mfma_f32_16x16x32_bf16((a), (b), (c), 0, 0, 0)
#define MFMA32(a, b, c) __builtin_amdgcn_mfma_f32_32x32x16_bf16((a), (b), (c), 0, 0, 0)
__device__ __forceinline__ bf16x8 pack8(const f32x16& x, int s) {
    u32x4 p;
    p[0] = pk2(x[8 * s + 0], x[8 * s + 1]); p[1] = pk2(x[8 * s + 2], x[8 * s + 3]);
    p[2] = pk2(x[8 * s + 4], x[8 * s + 5]); p[3] = pk2(x[8 * s + 6], x[8 * s + 7]);
    return __builtin_bit_cast(bf16x8, p);
}
__device__ __forceinline__ float wave_sum(float v) {
#pragma unroll
    for (int o = 1; o < 64; o <<= 1) v += __shfl_xor(v, o);
    return v;
}

namespace pg8 {
constexpr int BM = 256, BK = 64, HALF = 128, HTB = HALF * BK * 2, STAGE_BYTES = 8 * HTB, NXCD = 8, WGM = 8;
__host__ __device__ __forceinline__ int lds_byte(int r, int c) { const int st = (r >> 4) * 2 + (c >> 5), rr = r & 15, cc = c & 31, ob = rr * 64 + cc * 2; return st * 1024 + (ob ^ (((ob >> 9) & 1) << 5)); }
__host__ __device__ __forceinline__ void stage_rc(int b, int& R, int& C) { const int st = b / 1024, sb = b % 1024, swz = sb ^ (((sb >> 9) & 1) << 5); R = (st >> 1) * 16 + swz / 64; C = (st & 1) * 32 + (swz % 64) / 2; }
struct Unit { int pm, pn; };
struct Gemm { const bf16_t* A; const bf16_t* Bt; int M, N, K; };
struct StaticOrder {
    int nM, nN, nwg, G, c;
    __device__ void init(int M, int N, int G_, int c_) { nM = M / BM; nN = N / BM; nwg = nM * nN; G = G_; c = c_; }
    __device__ bool next(int i, Unit& u) const {
        const long L = (long)i * G + c; if (L >= nwg) return false;
        int wgid = (int)L; { const int q = nwg / NXCD, r = nwg % NXCD, xcd = wgid % NXCD, off = wgid / NXCD; wgid = (xcd < r ? xcd * (q + 1) : r * (q + 1) + (xcd - r) * q) + off; }
        const int nig = WGM * nN, gid = wgid / nig, fm = gid * WGM, gsz = (nM - fm) < WGM ? (nM - fm) : WGM;
        u.pm = fm + ((wgid % nig) % gsz); u.pn = (wgid % nig) / gsz; return true;
    }
};

template <class Epi>
__device__ __forceinline__ void gemm_phase(const Tb tb, LAS unsigned char* lds, const Gemm g, const StaticOrder& S, const Epi& E) {
    const int tid = tb.tid, wid = __builtin_amdgcn_readfirstlane(tid >> 6), lane = tid & 63, wr = wid >> 2, wc = wid & 3, fr = lane & 15, fq = lane >> 4;
    const int K = g.K, nt = K / BK;
    unsigned voffA[2], voffB[2];
#pragma unroll
    for (int i = 0; i < 2; ++i) { int R, C; stage_rc(tid * 16 + i * 8192, R, C); voffA[i] = (unsigned)(R * K + C) * 2u; voffB[i] = voffA[i]; }
    const size_t kstep = (size_t)(BK * 2);
    const size_t hstep = (size_t)HALF * K * 2;
    const size_t tstep = 2 * hstep;
    const unsigned ldsw = (unsigned)wid * 1024u;
    const int aoff = lds_byte(wr * 64 + fr, fq * 8), boff = lds_byte(wc * 32 + fr, fq * 8);
#define PG8_SA(b, h) (((b) * 2 + (h)) * HTB)
#define PG8_SB(b, h) ((4 + (b) * 2 + (h)) * HTB)
#define PG8_STAGE(bufoff, gbase, voff) do { _Pragma("unroll") for (int _i = 0; _i < 2; ++_i) \
        __builtin_amdgcn_global_load_lds((const unsigned*)((const char*)(gbase) + (voff)[_i]), (LAS unsigned*)(lds + (bufoff) + ldsw + _i * 8192), 16, 0, 0); } while (0)
#define PG8_LDA(dst, b, h) do { _Pragma("unroll") for (int m = 0; m < 4; ++m) _Pragma("unroll") for (int k = 0; k < 2; ++k) dst[m][k] = *(const LAS bf16x8*)(lds + PG8_SA(b, h) + aoff + m * 2048 + k * 1024); } while (0)
#define PG8_LDB(dst, b, h) do { _Pragma("unroll") for (int n = 0; n < 2; ++n) _Pragma("unroll") for (int k = 0; k < 2; ++k) dst[n][k] = *(const LAS bf16x8*)(lds + PG8_SB(b, h) + boff + n * 2048 + k * 1024); } while (0)
#define PG8_MMA(ai, bj, At, Bt) do { __builtin_amdgcn_s_setprio(1); _Pragma("unroll") for (int m = 0; m < 4; ++m) _Pragma("unroll") for (int n = 0; n < 2; ++n) _Pragma("unroll") for (int k = 0; k < 2; ++k) \
        acc[ai][bj][m][n] = __builtin_amdgcn_mfma_f32_16x16x32_bf16(Bt[n][k], At[m][k], acc[ai][bj][m][n], 0, 0, 0); __builtin_amdgcn_s_setprio(0); } while (0)
#define PG8_WAIT_V(n) asm volatile("s_waitcnt vmcnt(" #n ")" ::: "memory")
#define PG8_WAIT_L(n) asm volatile("s_waitcnt lgkmcnt(" #n ")" ::: "memory")
#define PG8_BAR __builtin_amdgcn_s_barrier()
#define PG8_SCHED __builtin_amdgcn_sched_barrier(0)
    Unit cur, nxt; int ui = 0;
    if (!S.next(0, cur)) return;
    f32x4 acc[2][2][4][2];
#pragma unroll
    for (int a = 0; a < 2; ++a)
#pragma unroll
        for (int b = 0; b < 2; ++b)
#pragma unroll
            for (int m = 0; m < 4; ++m)
#pragma unroll
                for (int n = 0; n < 2; ++n) acc[a][b][m][n] = (f32x4){0.f, 0.f, 0.f, 0.f};
    bf16x8 At[4][2], B0[2][2], B1[2][2];
    const char* cA = (const char*)g.A + (size_t)cur.pm * tstep; const char* cB = (const char*)g.Bt + (size_t)cur.pn * tstep;
    PG8_STAGE(PG8_SB(0, 0), cB, voffB); PG8_STAGE(PG8_SA(0, 0), cA, voffA); PG8_STAGE(PG8_SB(0, 1), cB + hstep, voffB); PG8_STAGE(PG8_SA(0, 1), cA + hstep, voffA);
    if (wr == 1) PG8_BAR;
    PG8_WAIT_V(4); PG8_BAR;
    PG8_STAGE(PG8_SB(1, 0), cB + kstep, voffB); PG8_STAGE(PG8_SA(1, 0), cA + kstep, voffA); PG8_STAGE(PG8_SB(1, 1), cB + hstep + kstep, voffB);
    PG8_WAIT_V(6); PG8_BAR;
    for (;;) {
        const bool has_next = S.next(ui + 1, nxt);
        const char* nA = has_next ? (const char*)g.A + (size_t)nxt.pm * tstep : cA; const char* nB = has_next ? (const char*)g.Bt + (size_t)nxt.pn * tstep : cB;
        for (int t = 0; t < nt; t += 2) {
            const bool last = (t == nt - 2);
            const char* a1 = cA + (size_t)(t + 1) * kstep;
            const char* a2 = last ? nA : cA + (size_t)(t + 2) * kstep; const char* b2 = last ? nB : cB + (size_t)(t + 2) * kstep;
            const char* a3 = a2 + kstep; const char* b3 = b2 + kstep;
            PG8_LDB(B0, 0, 0); PG8_SCHED; PG8_LDA(At, 0, 0); PG8_STAGE(PG8_SA(1, 1), a1 + hstep, voffA);
            PG8_WAIT_L(8); PG8_BAR; PG8_WAIT_L(0); PG8_MMA(0, 0, At, B0); PG8_BAR; PG8_SCHED;
            PG8_LDB(B1, 0, 1); PG8_STAGE(PG8_SB(0, 0), b2, voffB);
            PG8_BAR; PG8_WAIT_L(0); PG8_MMA(0, 1, At, B1); PG8_BAR;
            PG8_LDA(At, 0, 1); PG8_STAGE(PG8_SA(0, 0), a2, voffA);
            PG8_BAR; PG8_WAIT_L(0); PG8_MMA(1, 0, At, B0); PG8_BAR; PG8_SCHED;
            PG8_STAGE(PG8_SB(0, 1), b2 + hstep, voffB);
            PG8_WAIT_V(6); PG8_BAR; PG8_MMA(1, 1, At, B1); PG8_BAR;
            PG8_LDB(B0, 1, 0); PG8_SCHED; PG8_LDA(At, 1, 0); PG8_STAGE(PG8_SA(0, 1), a2 + hstep, voffA);
            PG8_WAIT_L(8); PG8_BAR; PG8_WAIT_L(0); PG8_MMA(0, 0, At, B0); PG8_BAR; PG8_SCHED;
            PG8_LDB(B1, 1, 1); PG8_STAGE(PG8_SB(1, 0), b3, voffB);
            PG8_BAR; PG8_WAIT_L(0); PG8_MMA(0, 1, At, B1); PG8_BAR;
            PG8_LDA(At, 1, 1); PG8_STAGE(PG8_SA(1, 0), a3, voffA);
            PG8_BAR; PG8_WAIT_L(0); PG8_MMA(1, 0, At, B0); PG8_BAR; PG8_SCHED;
            PG8_STAGE(PG8_SB(1, 1), b3 + hstep, voffB);
            PG8_WAIT_V(6); PG8_BAR; PG8_MMA(1, 1, At, B1); PG8_BAR;
        }
        E(acc, cur, wr, wc, fr, fq);
        if (!has_next) break;
#pragma unroll
        for (int a = 0; a < 2; ++a)
#pragma unroll
            for (int b = 0; b < 2; ++b)
#pragma unroll
                for (int m = 0; m < 4; ++m)
#pragma unroll
                    for (int n = 0; n < 2; ++n) acc[a][b][m][n] = (f32x4){0.f, 0.f, 0.f, 0.f};
        cur = nxt; cA = nA; cB = nB; ++ui;
    }
    PG8_WAIT_V(0);
    if (wr == 0) PG8_BAR;
    PG8_BAR;
#undef PG8_SA
#undef PG8_SB
#undef PG8_STAGE
#undef PG8_LDA
#undef PG8_LDB
#undef PG8_MMA
#undef PG8_WAIT_V
#undef PG8_WAIT_L
#undef PG8_BAR
#undef PG8_SCHED
}
}

__device__ __forceinline__ void row_stats(const float* mur, int row, float& mu, float& rstd) {
    if (mur) { const float2 v = *(const float2*)(mur + 2 * (size_t)row); mu = v.x; rstd = v.y; }
    else { mu = 0.f; rstd = 1.f; }
}
__device__ __forceinline__ void phase_statsfin(ArgsRef a, const Tb tb, int inst) {
    const float* part = (const float*)(a.ws + OFF_STATS) + (size_t)inst * T_ * 32;
    float* mur = (float*)(a.ws + OFF_MUR) + (size_t)inst * T_ * 2;
    const int gt = tb.bid * 512 + tb.tid, GT = tb.G * 512;
    for (int i = gt; i < T_ * 8; i += GT) {
        const int row = i >> 3, sub = i & 7;
        const f32x4 v = *(const f32x4*)(part + (size_t)row * 32 + sub * 4);
        float s = v[0] + v[2], q = v[1] + v[3];
        s += __shfl_xor(s, 1); q += __shfl_xor(q, 1); s += __shfl_xor(s, 2); q += __shfl_xor(q, 2); s += __shfl_xor(s, 4); q += __shfl_xor(q, 4);
        if (sub == 0) { const float mu = s * (1.f / 1024.f); const float var = fmaxf(q * (1.f / 1024.f) - mu * mu, 0.f); float2 o; o.x = mu; o.y = rsqrtf(var + LN_EPS_); *(float2*)(mur + 2 * (size_t)row) = o; }
    }
}
struct EpiGU {
    bf16_t* H; const float* stats; const float* c1; const float* c2;
    __device__ __forceinline__ void operator()(const f32x4 (&acc)[2][2][4][2], const pg8::Unit& u, int wr, int wc, int fr, int fq) const {
        const int row0 = u.pm * 256 + wr * 64 + fr, hcol0 = u.pn * 128 + wc * 32 + 4 * fq, ci0 = u.pn * 256 + wc * 32 + 4 * fq;
        f32x4 c1g[2], c2g[2], c1u[2], c2u[2];
#pragma unroll
        for (int n = 0; n < 2; ++n) { c1g[n] = *(const f32x4*)(c1 + ci0 + 16 * n); c2g[n] = *(const f32x4*)(c2 + ci0 + 16 * n); c1u[n] = *(const f32x4*)(c1 + ci0 + 128 + 16 * n); c2u[n] = *(const f32x4*)(c2 + ci0 + 128 + 16 * n); }
#pragma unroll
        for (int ai = 0; ai < 2; ++ai)
#pragma unroll
            for (int m = 0; m < 4; ++m) {
                const int row = row0 + ai * 128 + m * 16; float mu, rstd; row_stats(stats, row, mu, rstd);
#pragma unroll
                for (int n = 0; n < 2; ++n) {
                    float hv[4];
#pragma unroll
                    for (int j = 0; j < 4; ++j) {
                        const float gt = rstd * (acc[ai][0][m][n][j] - mu * c1g[n][j]) + c2g[n][j];
                        const float up = rstd * (acc[ai][1][m][n][j] - mu * c1u[n][j]) + c2u[n][j];
                        hv[j] = gt * __builtin_amdgcn_rcpf(1.f + __expf(-gt)) * up;
                    }
                    u32x2 w; w.x = pk2(hv[0], hv[1]); w.y = pk2(hv[2], hv[3]);
                    *(u32x2*)(H + (size_t)row * FF_ + hcol0 + 16 * n) = w;
                }
            }
    }
};
struct EpiRes {
    float* Yout; bf16_t* YB; const float* stats_prev; const float* lng; const float* lnb; float* stats_new; float coef;
    __device__ __forceinline__ void operator()(const f32x4 (&acc)[2][2][4][2], const pg8::Unit& u, int wr, int wc, int fr, int fq) const {
        const int row0 = u.pm * 256 + wr * 64 + fr, col0 = u.pn * 256 + wc * 32 + 4 * fq;
#pragma unroll
        for (int ai = 0; ai < 2; ++ai)
#pragma unroll
            for (int m = 0; m < 4; ++m) {
                const int row = row0 + ai * 128 + m * 16; float mu, rstd; row_stats(stats_prev, row, mu, rstd);
                float s = 0.f, q = 0.f;
#pragma unroll
                for (int bj = 0; bj < 2; ++bj)
#pragma unroll
                    for (int n = 0; n < 2; ++n) {
                        const int col = col0 + bj * 128 + n * 16;
                        const u32x2 rb = *(const u32x2*)(YB + (size_t)row * D_ + col);
                        f32x4 r = (f32x4){bflo(rb.x), bfhi(rb.x), bflo(rb.y), bfhi(rb.y)};
                        if (stats_prev) { const f32x4 g4 = *(const f32x4*)(lng + col), b4 = *(const f32x4*)(lnb + col); r = (r - mu) * rstd * g4 + b4; }
                        const f32x4 y = r * ALPHA_ + acc[ai][bj][m][n] * coef;
                        if (Yout) *(f32x4*)(Yout + (size_t)row * D_ + col) = y;
                        else { u32x2 w; w.x = pk2(y[0], y[1]); w.y = pk2(y[2], y[3]); *(u32x2*)(YB + (size_t)row * D_ + col) = w; }
                        s += (y[0] + y[1]) + (y[2] + y[3]); q += (y[0] * y[0] + y[1] * y[1]) + (y[2] * y[2] + y[3] * y[3]);
                    }
                s += __shfl_xor(s, 16); s += __shfl_xor(s, 32); q += __shfl_xor(q, 16); q += __shfl_xor(q, 32);
                if (fq == 0) { float2 sq; sq.x = s; sq.y = q; *(float2*)(stats_new + (size_t)row * 32 + (u.pn * 4 + wc) * 2) = sq; }
            }
    }
};
struct EpiIn {
    const float* stats; const float* c1; const float* c2; bf16_t* QK; bf16_t* VT; bf16_t* PC; bf16_t* Z;
    __device__ __forceinline__ void operator()(const f32x4 (&acc)[2][2][4][2], const pg8::Unit& u, int wr, int wc, int fr, int fq) const {
        const int row0 = u.pm * 256 + wr * 64 + fr, cc0 = wc * 32 + 4 * fq, pn = u.pn;
        const float* c1p = c1 + pn * 256 + cc0; const float* c2p = c2 + pn * 256 + cc0;
        const bool isv = (pn == 2 || pn == 5);
        bf16_t* dst; unsigned ld;
        if (pn < 2) { dst = QK + pn * 256; ld = 1024; }
        else if (pn == 3 || pn == 4) { dst = QK + (pn - 1) * 256; ld = 1024; }
        else if (pn >= 12) { dst = Z + (pn - 12) * 256; ld = 512; }
        else if (isv) { dst = VT + (size_t)(pn == 5 ? 16 : 0) * 64 * 4096; ld = 0; }
        else { dst = PC + (pn - 6) * 256; ld = 1536; }
#pragma unroll 1
        for (int ai = 0; ai < 2; ++ai)
#pragma unroll
            for (int m = 0; m < 4; ++m) {
                const int row = row0 + ai * 128 + m * 16; float mu, rstd; row_stats(stats, row, mu, rstd);
                const unsigned vrow = (unsigned)(row >> 12) * (4u * 64u * 4096u) + (unsigned)(row & 4095);
#pragma unroll
                for (int bj = 0; bj < 2; ++bj)
#pragma unroll
                    for (int n = 0; n < 2; ++n) {
                        const int cc = bj * 128 + n * 16;
                        const f32x4 c1q = *(const f32x4*)(c1p + cc), c2q = *(const f32x4*)(c2p + cc);
                        const f32x4 a4 = ai ? acc[1][bj][m][n] : acc[0][bj][m][n];
                        const f32x4 v = (a4 - c1q * mu) * rstd + c2q;
                        const unsigned w0 = pk2(v[0], v[1]), w1 = pk2(v[2], v[3]);
                        if (!isv) { u32x2 w; w.x = w0; w.y = w1; *(u32x2*)(dst + ((unsigned)row * ld + (unsigned)(cc0 + cc))) = w; }
                        else {
                            bf16_t* p = dst + (vrow + (unsigned)(cc0 + cc) * 4096u);
                            p[0] = (bf16_t)(w0 & 0xffff); p[4096] = (bf16_t)(w0 >> 16); p[2 * 4096] = (bf16_t)(w1 & 0xffff); p[3 * 4096] = (bf16_t)(w1 >> 16);
                        }
                    }
            }
    }
};

__device__ __forceinline__ void pro_item(const Tb tb, const float* W, int K, int N, int src0, bf16_t* Bt, int dst0, const float* lng, const float* lnb, float* c1, float* c2, LAS float* tile, int kbeg, int kend) {
    const int tid = tb.tid, kk = tid >> 4, n4 = (tid & 15) * 4, n = tid >> 3, ks = (tid & 7) * 8;
    float s1 = 0.f, s2 = 0.f;
    const float* wp = W + (size_t)kk * N + src0 + n4;
    f32x4 nx0 = __builtin_nontemporal_load((const f32x4*)(wp + (size_t)kbeg * N)), nx1 = __builtin_nontemporal_load((const f32x4*)(wp + (size_t)(kbeg + 32) * N));
    for (int k0 = kbeg; k0 < kend; k0 += 64) {
        const f32x4 v0 = nx0, v1 = nx1;
        if (k0 + 64 < kend) { nx0 = __builtin_nontemporal_load((const f32x4*)(wp + (size_t)(k0 + 64) * N)); nx1 = __builtin_nontemporal_load((const f32x4*)(wp + (size_t)(k0 + 96) * N)); }
        tile[(n4 + 0) * 65 + kk] = v0[0]; tile[(n4 + 1) * 65 + kk] = v0[1]; tile[(n4 + 2) * 65 + kk] = v0[2]; tile[(n4 + 3) * 65 + kk] = v0[3];
        tile[(n4 + 0) * 65 + kk + 32] = v1[0]; tile[(n4 + 1) * 65 + kk + 32] = v1[1]; tile[(n4 + 2) * 65 + kk + 32] = v1[2]; tile[(n4 + 3) * 65 + kk + 32] = v1[3];
        __syncthreads();
        float v[8];
#pragma unroll
        for (int j = 0; j < 8; ++j) v[j] = tile[n * 65 + ks + j];
        if (lng) {
#pragma unroll
            for (int j = 0; j < 8; ++j) { s2 += lnb[k0 + ks + j] * v[j]; v[j] *= lng[k0 + ks + j]; }
        }
        u32x4 o; o[0] = pk2(v[0], v[1]); o[1] = pk2(v[2], v[3]); o[2] = pk2(v[4], v[5]); o[3] = pk2(v[6], v[7]);
#pragma unroll
        for (int j = 0; j < 4; ++j) s1 += bflo(o[j]) + bfhi(o[j]);
        *(u32x4*)(Bt + (size_t)(dst0 + n) * K + k0 + ks) = o;
        __syncthreads();
    }
    s1 += __shfl_xor(s1, 1); s1 += __shfl_xor(s1, 2); s1 += __shfl_xor(s1, 4);
    s2 += __shfl_xor(s2, 1); s2 += __shfl_xor(s2, 2); s2 += __shfl_xor(s2, 4);
    if (c1 && (tid & 7) == 0) { c1[dst0 + n] = s1; c2[dst0 + n] = s2; }
}

__device__ __forceinline__ void pro_part(ArgsRef a, const Tb tb, int l, int part, int vb, int VG, LAS unsigned char* lds) {
    unsigned char* ws = a.ws;
    LAS float* tile = (LAS float*)lds;
    const float* ln_g = a.in[5]; const float* ln_b = a.in[6];
    const float* g_ffn1 = l > 0 ? ln_g + ((l - 1) * 3 + 2) * D_ : nullptr; const float* b_ffn1 = l > 0 ? ln_b + ((l - 1) * 3 + 2) * D_ : nullptr;
    const float* g_mix = ln_g + (l * 3 + 0) * D_; const float* b_mix = ln_b + (l * 3 + 0) * D_;
    const float* g_ffn2 = ln_g + (l * 3 + 1) * D_; const float* b_ffn2 = ln_b + (l * 3 + 1) * D_;
    if (part == 0) {
        for (int it = vb; it < 208; it += VG) {
            int r = it;
            if (r < 88) {
                const int np = r * 64, pn = np >> 8, bj = (np >> 7) & 1, x = np & 127, src = bj * FF_ + 128 * pn + x;
                float* c12 = (float*)(ws + OFF_C12GU0);
                pro_item(tb, a.in[1] + (size_t)l * D_ * 2 * FF_, D_, 2 * FF_, src, (bf16_t*)(ws + OFF_WGU0), np, g_ffn1, b_ffn1, c12, c12 + 5632, tile, 0, D_);
                continue;
            }
            r -= 88;
            if (r < 56) { float* c12 = (float*)(ws + OFF_C12IN); pro_item(tb, a.in[7] + (size_t)l * D_ * NIN_, D_, NIN_, r * 64, (bf16_t*)(ws + OFF_WIN), r * 64, g_mix, b_mix, c12, c12 + 3584, tile, 0, D_); continue; }
            r -= 56;
            { const int q = (r >> 2) & 15, kq = r & 3;
              pro_item(tb, a.in[2] + (size_t)l * FF_ * D_, FF_, D_, q * 64, (bf16_t*)(ws + OFF_WDN0), q * 64, nullptr, nullptr, nullptr, nullptr, tile, kq * 704, kq * 704 + 704); }
        }
        if (vb == VG - 1) {
            const int wv = tb.tid >> 6, lane = tb.tid & 63;
            float* wg8 = (float*)(ws + OFF_WG8);
            const float* W = a.in[7] + (size_t)l * D_ * NIN_;
            float s1 = 0.f, s2 = 0.f;
            for (int k = lane; k < D_; k += 64) { const float w = W[(size_t)k * NIN_ + NING_ + wv]; const float wgv = w * g_mix[k]; wg8[wv * 1024 + k] = wgv; s1 += wgv; s2 += b_mix[k] * w; }
            s1 = wave_sum(s1); s2 = wave_sum(s2);
            if (lane == 0) { wg8[8192 + wv] = s1; wg8[8192 + 8 + wv] = s2; }
        }
        if (l == 0) {
            const size_t gt = (size_t)vb * 512 + tb.tid, GT = (size_t)VG * 512;
            const f32x4* x4 = (const f32x4*)a.in[0]; u32x2* yb = (u32x2*)(ws + OFF_YB);
            for (size_t i = gt; i < (size_t)T_ * D_ / 4; i += GT) { const f32x4 v = __builtin_nontemporal_load(x4 + i); u32x2 w; w.x = pk2(v[0], v[1]); w.y = pk2(v[2], v[3]); yb[i] = w; }
        }
    } else {
        for (int it = vb; it < 168; it += VG) {
            int r = it;
            if (r < 88) {
                const int np = r * 64, pn = np >> 8, bj = (np >> 7) & 1, x = np & 127, src = bj * FF_ + 128 * pn + x;
                float* c12 = (float*)(ws + OFF_C12GU1);
                pro_item(tb, a.in[3] + (size_t)l * D_ * 2 * FF_, D_, 2 * FF_, src, (bf16_t*)(ws + OFF_WGU1), np, g_ffn2, b_ffn2, c12, c12 + 5632, tile, 0, D_);
                continue;
            }
            r -= 88;
            if (r < 16) { pro_item(tb, a.in[15] + (size_t)l * D_ * D_, D_, D_, r * 64, (bf16_t*)(ws + OFF_WOUT), r * 64, nullptr, nullptr, nullptr, nullptr, tile, 0, D_); continue; }
            r -= 16;
            { const int q = (r >> 2) & 15, kq = r & 3;
              pro_item(tb, a.in[4] + (size_t)l * FF_ * D_, FF_, D_, q * 64, (bf16_t*)(ws + OFF_WDN1), q * 64, nullptr, nullptr, nullptr, nullptr, tile, kq * 704, kq * 704 + 704); }
        }
    }
}

__device__ __forceinline__ void phase_gates(ArgsRef a, const Tb tb, int l) {
    unsigned char* ws = a.ws;
    const float* wg8 = (const float*)(ws + OFF_WG8);
    const float* stats = (const float*)(ws + OFF_MUR) + (size_t)(l * 3 + 0) * T_ * 2;
    float* gates = (float*)(ws + OFF_GATES);
    const bf16_t* YBp = (const bf16_t*)(ws + OFF_YB);
    const int wv = tb.tid >> 6, lane = tb.tid & 63;
    const int gw = tb.bid * 8 + wv, GW = tb.G * 8;
    for (int t = gw; t < T_; t += GW) {
        f32x4 y[4];
#pragma unroll
        for (int i = 0; i < 4; ++i) { const u32x2 rb = *(const u32x2*)(YBp + (size_t)t * D_ + i * 256 + lane * 4); y[i] = (f32x4){bflo(rb.x), bfhi(rb.x), bflo(rb.y), bfhi(rb.y)}; }
        float mu, rstd; row_stats(stats, t, mu, rstd);
        float s8[8];
#pragma unroll
        for (int j = 0; j < 8; ++j) { float s = 0.f;
#pragma unroll
            for (int i = 0; i < 4; ++i) { const f32x4 w = *(const f32x4*)(wg8 + j * 1024 + i * 256 + lane * 4); s += (y[i][0] * w[0] + y[i][1] * w[1]) + (y[i][2] * w[2] + y[i][3] * w[3]); }
            s8[j] = s; }
        const bool b5 = (lane & 32) != 0, b4 = (lane & 16) != 0, b3 = (lane & 8) != 0;
        float r4[4], q2[2];
#pragma unroll
        for (int j = 0; j < 4; ++j) { const float keep = b5 ? s8[j + 4] : s8[j], send = b5 ? s8[j] : s8[j + 4]; r4[j] = keep + __shfl_xor(send, 32); }
#pragma unroll
        for (int j = 0; j < 2; ++j) { const float keep = b4 ? r4[j + 2] : r4[j], send = b4 ? r4[j] : r4[j + 2]; q2[j] = keep + __shfl_xor(send, 16); }
        float dv = (b3 ? q2[1] : q2[0]) + __shfl_xor(b3 ? q2[0] : q2[1], 8);
        dv += __shfl_xor(dv, 4); dv += __shfl_xor(dv, 2); dv += __shfl_xor(dv, 1);
        if ((lane & 7) == 0) {
            const int j = lane >> 3;
            const float v = rstd * (dv - mu * wg8[8192 + j]) + wg8[8192 + 8 + j];
            float o;
            if (j < 4) o = 1.f / (1.f + expf(-v));
            else { const int h = j - 4; const float xx = v + a.in[10][l * 4 + h]; const float sp = fmaxf(xx, 0.f) + log1pf(expf(-fabsf(xx))); o = -expf(a.in[9][l * 4 + h]) * sp; }
            gates[(size_t)t * 8 + (j < 4 ? 4 + j : j - 4)] = o;
        }
    }
}

__device__ __forceinline__ float xor32_max(float v) { const unsigned u = __float_as_uint(v); auto r = __builtin_amdgcn_permlane32_swap(u, u, false, false); return fmaxf(__uint_as_float(r[0]), __uint_as_float(r[1])); }
__device__ __forceinline__ float xor32_get(float v, int h) { const unsigned u = __float_as_uint(v); auto r = __builtin_amdgcn_permlane32_swap(u, u, false, false); return __uint_as_float(h ? r[0] : r[1]); }
__device__ __forceinline__ bf16x8 ldg8(const bf16_t* p) { return *(const bf16x8*)p; }
__device__ __forceinline__ bf16x8 ldsf(LAS const unsigned char* p) { return *(LAS const bf16x8*)p; }
constexpr int AT_ROW = 144, AT_K = 0, AT_V = 64 * AT_ROW, AT_BUF = 2 * 64 * AT_ROW;

template <bool DIAG>
__device__ __forceinline__ void diff_subtile(const bf16x8 (&kf)[4], const bf16x8 (&v)[2][2], const bf16x8 (&q1)[2], const bf16x8 (&q2)[2], f32x16 (&o1)[2], f32x16 (&o2)[2],
                                             float& m1, float& m2, float& l1, float& l2, int r, int h) {
    const float c = 0.17677669529663687f * 1.4426950408889634f;
    const float LAZY_THR = 8.f / c;
    const bf16x8 k1[2] = {kf[0], kf[1]}, k2[2] = {kf[2], kf[3]};
    f32x16 s1, s2;
#pragma unroll
    for (int i = 0; i < 16; ++i) { s1[i] = 0.f; s2[i] = 0.f; }
    s1 = MFMA32(k1[0], q1[0], s1); s1 = MFMA32(k1[1], q1[1], s1);
    s2 = MFMA32(k2[0], q2[0], s2); s2 = MFMA32(k2[1], q2[1], s2);
    if (DIAG) {
#pragma unroll
        for (int i = 0; i < 16; ++i) { const int kk = 16 * (i >> 3) + 8 * h + (i & 7); if (kk > r) { s1[i] = -INFINITY; s2[i] = -INFINITY; } }
    }
    {
        float mx = s1[0];
#pragma unroll
        for (int i = 1; i < 16; ++i) mx = fmaxf(mx, s1[i]);
        mx = xor32_max(mx);
        if (__any(mx > m1 + LAZY_THR)) {
            const float mn = fmaxf(m1, mx), al = exp2f((m1 - mn) * c); m1 = mn; l1 *= al;
#pragma unroll
            for (int i = 0; i < 16; ++i) { o1[0][i] *= al; o1[1][i] *= al; }
        }
        float ls = 0.f; const float mc = m1 * c;
#pragma unroll
        for (int i = 0; i < 16; ++i) { s1[i] = __builtin_amdgcn_exp2f(s1[i] * c - mc); ls += s1[i]; }
        l1 += ls;
        const bf16x8 p0 = pack8(s1, 0), p1 = pack8(s1, 1);
        o1[0] = MFMA32(v[0][0], p0, o1[0]); o1[0] = MFMA32(v[0][1], p1, o1[0]);
        o1[1] = MFMA32(v[1][0], p0, o1[1]); o1[1] = MFMA32(v[1][1], p1, o1[1]);
    }
    {
        float mx = s2[0];
#pragma unroll
        for (int i = 1; i < 16; ++i) mx = fmaxf(mx, s2[i]);
        mx = xor32_max(mx);
        if (__any(mx > m2 + LAZY_THR)) {
            const float mn = fmaxf(m2, mx), al = exp2f((m2 - mn) * c); m2 = mn; l2 *= al;
#pragma unroll
            for (int i = 0; i < 16; ++i) { o2[0][i] *= al; o2[1][i] *= al; }
        }
        float ls = 0.f; const float mc = m2 * c;
#pragma unroll
        for (int i = 0; i < 16; ++i) { s2[i] = __builtin_amdgcn_exp2f(s2[i] * c - mc); ls += s2[i]; }
        l2 += ls;
        const bf16x8 p0 = pack8(s2, 0), p1 = pack8(s2, 1);
        o2[0] = MFMA32(v[0][0], p0, o2[0]); o2[0] = MFMA32(v[0][1], p1, o2[0]);
        o2[1] = MFMA32(v[1][0], p0, o2[1]); o2[1] = MFMA32(v[1][1], p1, o2[1]);
    }
}

template <bool DIAG>
__device__ __forceinline__ void stick_subtile(const bf16x8 (&k)[4], const bf16x8 (&v)[2][2], const bf16x8 (&q)[4], f32x16 (&o)[2], float& run, int r, int h) {
    f32x16 z;
#pragma unroll
    for (int i = 0; i < 16; ++i) z[i] = 0.f;
#pragma unroll
    for (int s = 0; s < 4; ++s) z = MFMA32(k[s], q[s], z);
    f32x16 be, sy;
#pragma unroll
    for (int i = 0; i < 16; ++i) { const float t = __expf(-fmaxf(z[i] * 0.125f, -80.f)); const float rc = __builtin_amdgcn_rcpf(1.f + t); be[i] = rc; sy[i] = t * rc; }
    if (DIAG) {
#pragma unroll
        for (int i = 0; i < 16; ++i) { const int kk = 16 * (i >> 3) + 8 * h + (i & 7); if (kk >= r) { be[i] = 0.f; sy[i] = 1.f; } }
    }
    f32x16 suf; float tot[2];
#pragma unroll
    for (int gq = 0; gq < 2; ++gq) {
        float acc = 1.f;
#pragma unroll
        for (int j = 7; j >= 0; --j) { suf[8 * gq + j] = acc; acc *= sy[8 * gq + j]; }
        tot[gq] = acc;
    }
    const float pt0 = xor32_get(tot[0], h), pt1 = xor32_get(tot[1], h);
    const float after0 = run * (h ? (pt1 * tot[1]) : (pt0 * tot[1] * pt1));
    const float after1 = run * (h ? 1.f : pt1);
    f32x16 w;
#pragma unroll
    for (int i = 0; i < 16; ++i) w[i] = be[i] * (i < 8 ? after0 : after1) * suf[i];
    run *= (tot[0] * tot[1]) * (pt0 * pt1);
    const bf16x8 p0 = pack8(w, 0), p1 = pack8(w, 1);
    o[0] = MFMA32(v[0][0], p0, o[0]); o[0] = MFMA32(v[0][1], p1, o[0]);
    o[1] = MFMA32(v[1][0], p0, o[1]); o[1] = MFMA32(v[1][1], p1, o[1]);
}

template <int TYPE>
__device__ __forceinline__ void attn_unit(const bf16_t* QK, const bf16_t* VT, bf16_t* O, int bh, int qb, float lam, const float* normg, float outscale, int tid, LAS unsigned char* lds) {
    const int wv = tid >> 6, lane = tid & 63, r = lane & 31, h = lane >> 5, b = bh >> 2, hd = bh & 3;
    const int qg = qb * 8 + wv, q0 = qg * 32, ntile = (qb + 1) * 4;
    const size_t tok0 = (size_t)b * SEQ_;
    const bf16_t* qrow = QK + (tok0 + q0 + r) * 1024 + (TYPE ? 512 : 0) + hd * 64;
    bf16x8 q[4];
#pragma unroll
    for (int s = 0; s < 4; ++s) q[s] = ldg8(qrow + 16 * s + 8 * h);
    const bf16_t* kg = QK + (tok0 + (tid >> 3)) * 1024 + (TYPE ? 768 : 256) + hd * 64 + (tid & 7) * 8;
    const bf16_t* vg = VT + ((size_t)(TYPE ? 16 : 0) + bh) * 64 * 4096 + (size_t)(tid >> 3) * 4096 + (tid & 7) * 8;
    const unsigned lk = AT_K + (tid >> 3) * AT_ROW + (tid & 7) * 16, lv = AT_V + (tid >> 3) * AT_ROW + (tid & 7) * 16;
    const unsigned fk = AT_K + swap23(r) * AT_ROW + 16 * h, fv = AT_V + r * AT_ROW + 16 * h;
    f32x16 o1[2], o2[2];
#pragma unroll
    for (int i = 0; i < 16; ++i) { o1[0][i] = 0.f; o1[1][i] = 0.f; o2[0][i] = 0.f; o2[1][i] = 0.f; }
    float m1 = -INFINITY, m2 = -INFINITY, l1 = 0.f, l2 = 0.f, run = 1.f;
    {
        const int tt = TYPE ? ntile - 1 : 0;
        const u32x4 kx = *(const u32x4*)(kg + (size_t)tt * 64 * 1024), vx = *(const u32x4*)(vg + tt * 64);
        *(LAS u32x4*)(lds + lk) = kx; *(LAS u32x4*)(lds + lv) = vx;
    }
    __syncthreads();
    for (int it = 0; it < ntile; ++it) {
        const int tt = TYPE ? ntile - 1 - it : it;
        u32x4 kx, vx;
        if (it + 1 < ntile) { const int tn = TYPE ? tt - 1 : tt + 1; kx = *(const u32x4*)(kg + (size_t)tn * 64 * 1024); vx = *(const u32x4*)(vg + tn * 64); }
        LAS const unsigned char* L = lds + (it & 1) * AT_BUF;
        bf16x8 kf[2][4], vf[2][2][2];
#pragma unroll
        for (int st = 0; st < 2; ++st) {
#pragma unroll
            for (int s4 = 0; s4 < 4; ++s4) kf[st][s4] = ldsf(L + fk + st * 32 * AT_ROW + 32 * s4);
#pragma unroll
            for (int mt = 0; mt < 2; ++mt)
#pragma unroll
                for (int s2 = 0; s2 < 2; ++s2) vf[st][mt][s2] = ldsf(L + fv + st * 64 + mt * 32 * AT_ROW + 32 * s2);
        }
#pragma unroll
        for (int ss = 0; ss < 2; ++ss) {
            const int st = TYPE ? 1 - ss : ss, kt = 2 * tt + st;
            const bf16x8 (&qa)[2] = *(const bf16x8 (*)[2])&q[0]; const bf16x8 (&qb2)[2] = *(const bf16x8 (*)[2])&q[2];
            if (kt < qg) {
                if (TYPE == 0) diff_subtile<false>(kf[st], vf[st], qa, qb2, o1, o2, m1, m2, l1, l2, r, h);
                else stick_subtile<false>(kf[st], vf[st], q, o1, run, r, h);
            } else if (kt == qg) {
                if (TYPE == 0) diff_subtile<true>(kf[st], vf[st], qa, qb2, o1, o2, m1, m2, l1, l2, r, h);
                else stick_subtile<true>(kf[st], vf[st], q, o1, run, r, h);
            }
        }
        if (it + 1 < ntile) { LAS unsigned char* Ln = lds + ((it + 1) & 1) * AT_BUF; *(LAS u32x4*)(Ln + lk) = kx; *(LAS u32x4*)(Ln + lv) = vx; }
        __syncthreads();
    }
    float ss = 0.f;
    if (TYPE == 0) {
        l1 += __shfl_xor(l1, 32); l2 += __shfl_xor(l2, 32);
        const float i1 = 1.f / l1, i2 = lam / l2;
#pragma unroll
        for (int mt = 0; mt < 2; ++mt)
#pragma unroll
            for (int i = 0; i < 16; ++i) { const float vv = o1[mt][i] * i1 - o2[mt][i] * i2; o1[mt][i] = vv; ss += vv * vv; }
    } else {
#pragma unroll
        for (int mt = 0; mt < 2; ++mt)
#pragma unroll
            for (int i = 0; i < 16; ++i) ss += o1[mt][i] * o1[mt][i];
    }
    ss += __shfl_xor(ss, 32);
    const float rn = rsqrtf(ss * (1.f / 64.f) + RMS_EPS_) * outscale;
    bf16_t* orow = O + (tok0 + q0 + r) * 1024 + (TYPE ? 256 : 0) + hd * 64;
#pragma unroll
    for (int mt = 0; mt < 2; ++mt)
#pragma unroll
        for (int g4 = 0; g4 < 4; ++g4) {
            const int dv0 = 32 * mt + 8 * g4 + 4 * h;
            const f32x4 gg = *(const f32x4*)(normg + dv0);
            u32x2 w; w.x = pk2(o1[mt][4 * g4 + 0] * rn * gg[0], o1[mt][4 * g4 + 1] * rn * gg[1]); w.y = pk2(o1[mt][4 * g4 + 2] * rn * gg[2], o1[mt][4 * g4 + 3] * rn * gg[3]);
            *(u32x2*)(orow + dv0) = w;
        }
}

__device__ __forceinline__ void phase_attn(ArgsRef a, const Tb tb, int l, LAS unsigned char* lds) {
    unsigned char* ws = a.ws;
    const bf16_t* QK = (const bf16_t*)(ws + OFF_QK); const bf16_t* VT = (const bf16_t*)(ws + OFF_VT); bf16_t* O = (bf16_t*)(ws + OFF_O);
    const int lane = tb.tid & 63;
    const float lambda_init = 0.8f - 0.6f * expf(-0.3f * (float)l);
    const float* dl = a.in[12] + l * 128;
    float p01 = 0.f, p23 = 0.f;
    if (lane < 32) { p01 = dl[lane] * dl[32 + lane]; p23 = dl[64 + lane] * dl[96 + lane]; }
    p01 = wave_sum(p01); p23 = wave_sum(p23);
    const float lam = expf(p01) - expf(p23) + lambda_init;
    for (int u = tb.bid; u < 256; u += tb.G) {
        const int bh = (u & 7) + 8 * ((u >> 3) & 1), qb = u >> 4;
        attn_unit<0>(QK, VT, O, bh, qb, lam, a.in[13] + l * 64, 1.f - lambda_init, tb.tid, lds);
        attn_unit<1>(QK, VT, O, bh, 15 - qb, 0.f, a.in[14] + l * 64, 1.f, tb.tid, lds);
    }
}

constexpr int KB_LD = 136;
__device__ __forceinline__ void phase_dnprep(ArgsRef a, const Tb tb, int l, LAS unsigned char* lds) {
    unsigned char* ws = a.ws;
    const bf16_t* PC = (const bf16_t*)(ws + OFF_PC);
    const float* gates = (const float*)(ws + OFF_GATES);
    bf16_t* DW = (bf16_t*)(ws + OFF_DNW); bf16_t* DQG = (bf16_t*)(ws + OFF_DNQG); bf16_t* DKGT = (bf16_t*)(ws + OFF_DNKGT); bf16_t* DU = (bf16_t*)(ws + OFF_DNU); bf16_t* DA = (bf16_t*)(ws + OFF_DNA);
    float* EGL = (float*)(ws + OFF_EGL);
    const float* convw = a.in[8] + (size_t)l * 4 * 1536;
    LAS float* Lm = (LAS float*)lds;
    LAS float* gcs = Lm + 64 * 64;
    LAS float* betas = gcs + 64;
    LAS bf16_t* kb16 = (LAS bf16_t*)(betas + 64);
    LAS bf16_t* qb16 = kb16 + 64 * KB_LD;
    LAS float* rhs = (LAS float*)(qb16 + 64 * KB_LD);
    const int tid = tb.tid, wv = tid >> 6, lane = tid & 63;
    for (int ci = tb.bid; ci < 1024; ci += tb.G) {
        const int b = ci >> 8, h = (ci >> 6) & 3, n = ci & 63;
        const size_t t0 = (size_t)b * SEQ_ + n * 64;
        __syncthreads();
        if (wv == 0) {
            float g = gates[(t0 + lane) * 8 + h]; const float be = gates[(t0 + lane) * 8 + 4 + h];
#pragma unroll
            for (int o = 1; o < 64; o <<= 1) { const float t = __shfl_up(g, o); if (lane >= o) g += t; }
            gcs[lane] = g; betas[lane] = be;
            if (lane == 63) EGL[ci] = __expf(g);
        }
        __syncthreads();
        {
            const int row = tid >> 3, seg = tid & 7, cb = seg * 16;
            const float gci = gcs[row], bi = betas[row], eg = __expf(gci), egl = __expf(gcs[63] - gci);
            float val[3][16];
#pragma unroll
            for (int part = 0; part < 3; ++part) {
                const int col0 = part * 512 + h * 128 + cb;
#pragma unroll
                for (int c = 0; c < 16; ++c) val[part][c] = 0.f;
#pragma unroll
                for (int j = 0; j < 4; ++j) {
                    const int srow = n * 64 + row - 3 + j;
                    if (srow >= 0) {
                        const bf16_t* xp = PC + ((size_t)b * SEQ_ + srow) * 1536 + col0;
                        const u32x4 x0 = *(const u32x4*)xp, x1 = *(const u32x4*)(xp + 8);
                        const float* wp = convw + j * 1536 + col0;
#pragma unroll
                        for (int c4 = 0; c4 < 4; ++c4) {
                            const f32x4 w4 = *(const f32x4*)(wp + 4 * c4);
                            const unsigned xa = c4 < 2 ? x0[2 * c4] : x1[2 * (c4 - 2)], xb = c4 < 2 ? x0[2 * c4 + 1] : x1[2 * (c4 - 2) + 1];
                            val[part][4 * c4 + 0] += w4[0] * bflo(xa); val[part][4 * c4 + 1] += w4[1] * bfhi(xa);
                            val[part][4 * c4 + 2] += w4[2] * bflo(xb); val[part][4 * c4 + 3] += w4[3] * bfhi(xb);
                        }
                    }
                }
#pragma unroll
                for (int c = 0; c < 16; ++c) { const float x = val[part][c]; val[part][c] = x * __builtin_amdgcn_rcpf(1.f + __expf(-x)); }
            }
            float sq = 0.f, sk = 0.f;
#pragma unroll
            for (int c = 0; c < 16; ++c) { sq += val[0][c] * val[0][c]; sk += val[1][c] * val[1][c]; }
            sq += __shfl_xor(sq, 1); sq += __shfl_xor(sq, 2); sq += __shfl_xor(sq, 4);
            sk += __shfl_xor(sk, 1); sk += __shfl_xor(sk, 2); sk += __shfl_xor(sk, 4);
            const float rq = rsqrtf(sq + RMS_EPS_) * 0.08838834764831845f, rk = rsqrtf(sk + RMS_EPS_);
            unsigned qp[8], kp[8], qgp[8];
#pragma unroll
            for (int c = 0; c < 16; ++c) { val[0][c] *= rq; val[1][c] *= rk; }
#pragma unroll
            for (int c = 0; c < 8; ++c) { qp[c] = pk2(val[0][2 * c], val[0][2 * c + 1]); kp[c] = pk2(val[1][2 * c], val[1][2 * c + 1]); qgp[c] = pk2(val[0][2 * c] * eg, val[0][2 * c + 1] * eg); }
            *(LAS u32x4*)(qb16 + row * KB_LD + cb) = (u32x4){qp[0], qp[1], qp[2], qp[3]}; *(LAS u32x4*)(qb16 + row * KB_LD + cb + 8) = (u32x4){qp[4], qp[5], qp[6], qp[7]};
            *(LAS u32x4*)(kb16 + row * KB_LD + cb) = (u32x4){kp[0], kp[1], kp[2], kp[3]}; *(LAS u32x4*)(kb16 + row * KB_LD + cb + 8) = (u32x4){kp[4], kp[5], kp[6], kp[7]};
            bf16_t* qgd = DQG + ((size_t)ci * 64 + row) * 128 + (cb & ~31) + 4 * ((cb >> 4) & 1);
#pragma unroll
            for (int f = 0; f < 4; ++f) { u32x2 w2; w2.x = qgp[2 * f]; w2.y = qgp[2 * f + 1]; *(u32x2*)(qgd + 8 * f) = w2; }
#pragma unroll
            for (int c = 0; c < 16; ++c) {
                rhs[row * 256 + cb + c] = val[2][c] * bi;
                rhs[row * 256 + 128 + cb + c] = val[1][c] * bi * eg;
                const unsigned kg = pk2(val[1][c] * egl, 0.f);
                DKGT[((size_t)ci * 128 + cb + c) * 64 + (row & 32) + perm32k(row & 31)] = (bf16_t)(kg & 0xffff);
            }
        }
        __syncthreads();
        {
            const int mat = wv >> 2, ti = (wv >> 1) & 1, tj = wv & 1, r = lane & 31, hh = lane >> 5;
            f32x16 cacc;
#pragma unroll
            for (int i = 0; i < 16; ++i) cacc[i] = 0.f;
            if (tj <= ti) {
                LAS const bf16_t* ap = (mat ? qb16 : kb16) + (32 * ti + r) * KB_LD + 8 * hh;
                LAS const bf16_t* bp = kb16 + (32 * tj + r) * KB_LD + 8 * hh;
#pragma unroll
                for (int s = 0; s < 8; ++s) { const bf16x8 af = *(LAS const bf16x8*)(ap + 16 * s), bf = *(LAS const bf16x8*)(bp + 16 * s); cacc = MFMA32(af, bf, cacc); }
            }
            const int col = 32 * tj + r; const float gcol = gcs[col];
#pragma unroll
            for (int i = 0; i < 16; ++i) {
                const int row = 32 * ti + crow(i, hh);
                const float dec = (row >= col) ? __expf(gcs[row] - gcol) : 0.f;
                if (mat == 0) Lm[row * 64 + col] = (col < row) ? betas[row] * cacc[i] * dec : 0.f;
                else { const unsigned av = pk2((col <= row) ? cacc[i] * dec : 0.f, 0.f); DA[((size_t)ci * 64 + row) * 64 + (col & 32) + perm32k(col & 31)] = (bf16_t)(av & 0xffff); }
            }
        }
        __syncthreads();
        if (tid < 256) {
            const int col = tid;
            float acc[64];
#pragma unroll
            for (int i = 0; i < 64; ++i) acc[i] = rhs[i * 256 + col];
#pragma unroll
            for (int jp = 0; jp < 16; ++jp) {
                const int r0 = 4 * jp;
                const f32x4 d1 = *(LAS const f32x4*)(Lm + (r0 + 1) * 64 + r0), d2 = *(LAS const f32x4*)(Lm + (r0 + 2) * 64 + r0), d3 = *(LAS const f32x4*)(Lm + (r0 + 3) * 64 + r0);
                const float x0 = acc[r0];
                const float x1 = acc[r0 + 1] - d1[0] * x0;
                const float x2 = (acc[r0 + 2] - d2[0] * x0) - d2[1] * x1;
                const float x3 = ((acc[r0 + 3] - d3[0] * x0) - d3[1] * x1) - d3[2] * x2;
                rhs[(r0 + 0) * 256 + col] = x0; rhs[(r0 + 1) * 256 + col] = x1; rhs[(r0 + 2) * 256 + col] = x2; rhs[(r0 + 3) * 256 + col] = x3;
#pragma unroll
                for (int i = r0 + 4; i < 64; ++i) {
                    const f32x4 l4 = *(LAS const f32x4*)(Lm + i * 64 + r0);
                    acc[i] = (((acc[i] - l4[0] * x0) - l4[1] * x1) - l4[2] * x2) - l4[3] * x3;
                }
            }
        }
        __syncthreads();
        {
            const int row = tid >> 3, cb = (tid & 7) * 16;
            LAS const float* xp = rhs + row * 256 + 128 + cb;
            unsigned p[8];
#pragma unroll
            for (int c = 0; c < 8; ++c) p[c] = pk2(xp[2 * c], xp[2 * c + 1]);
            bf16_t* wd = DW + ((size_t)ci * 64 + row) * 128 + (cb & ~31) + 4 * ((cb >> 4) & 1);
#pragma unroll
            for (int f = 0; f < 4; ++f) { u32x2 w2; w2.x = p[2 * f]; w2.y = p[2 * f + 1]; *(u32x2*)(wd + 8 * f) = w2; }
            const int slice = tid >> 6, lp = tid & 63, fq = lp >> 4, fr = lp & 15;
            LAS const float* up = rhs + (4 * fq) * 256 + slice * 16 + fr;
            unsigned q[8];
#pragma unroll
            for (int e = 0; e < 8; ++e) { const int t = e >> 1, rg = (e & 1) * 2; q[e] = pk2(up[(16 * t + rg) * 256], up[(16 * t + rg + 1) * 256]); }
            bf16_t* ud = DU + (((size_t)ci * 8 + slice) * 64 + lp) * 16;
            *(u32x4*)ud = (u32x4){q[0], q[1], q[2], q[3]}; *(u32x4*)(ud + 8) = (u32x4){q[4], q[5], q[6], q[7]};
        }
    }
    __syncthreads();
}

constexpr int SC_W = 0, SC_QG = 64 * 272, SC_A = 2 * 64 * 272, SC_KGT = SC_A + 64 * 144, SC_U = SC_KGT + 128 * 144, SC_BUF = SC_U + 2048, SC_EG = 2 * SC_BUF;
static_assert(SC_EG + 256 <= 131072, "scan LDS");
__device__ __forceinline__ bf16x8 lds8(LAS const unsigned char* p) { return *(LAS const bf16x8*)p; }
__device__ __forceinline__ void phase_dnscan(ArgsRef a, const Tb tb, LAS unsigned char* lds) {
    if (tb.bid >= 128) return;
    unsigned char* ws = a.ws;
    const unsigned char* DW = ws + OFF_DNW; const unsigned char* DQG = ws + OFF_DNQG; const unsigned char* DKGT = ws + OFF_DNKGT; const unsigned char* DA = ws + OFF_DNA;
    const bf16_t* DU = (const bf16_t*)(ws + OFF_DNU);
    const float* EGL = (const float*)(ws + OFF_EGL);
    float* OC = (float*)(ws + OFF_OCRAW);
    const int tid = tb.tid, wv = tid >> 6, lane = tid & 63;
    const int bh = (tb.bid & 7) + 8 * ((tb.bid >> 3) & 1), slice = tb.bid >> 4, b = bh >> 2, h = bh & 3;
    unsigned goff[8], loff[8]; int garr[8];
    const int lt = tid - 64;
#pragma unroll
    for (int i = 0; i < 8; ++i) {
        const int p = lt + 448 * i;
        int arr, q;
        if (p < 1024) { arr = 0; q = p; } else if (p < 2048) { arr = 1; q = p - 1024; } else if (p < 2560) { arr = 2; q = p - 2048; } else { arr = 3; q = p - 2560; }
        garr[i] = arr; goff[i] = (unsigned)q * 16u;
        if (arr < 2) loff[i] = (unsigned)((arr ? SC_QG : SC_W) + (q >> 4) * 272 + (q & 15) * 16);
        else loff[i] = (unsigned)((arr == 2 ? SC_A : SC_KGT) + (q >> 3) * 144 + (q & 7) * 16);
    }
    auto load_chunk = [&](int ci, u32x4 (&v)[9]) {
#pragma unroll
        for (int i = 0; i < 8; ++i) {
            const unsigned char* base = garr[i] == 0 ? DW + (size_t)ci * 16384 : garr[i] == 1 ? DQG + (size_t)ci * 16384 : garr[i] == 2 ? DA + (size_t)ci * 8192 : DKGT + (size_t)ci * 16384;
            v[i] = *(const u32x4*)(base + goff[i]);
        }
        if (lt < 128) v[8] = *(const u32x4*)((const unsigned char*)DU + ((size_t)ci * 8 + slice) * 2048 + lt * 16);
    };
    auto store_chunk = [&](int buf, const u32x4 (&v)[9]) {
#pragma unroll
        for (int i = 0; i < 8; ++i) *(LAS u32x4*)(lds + buf * SC_BUF + loff[i]) = v[i];
        if (lt < 128) *(LAS u32x4*)(lds + buf * SC_BUF + SC_U + lt * 16) = v[8];
    };
#define SC_BARRIER() do { asm volatile("s_waitcnt lgkmcnt(0)" ::: "memory"); __builtin_amdgcn_s_barrier(); asm volatile("" ::: "memory"); } while (0)
    if (wv > 0) {
        u32x4 l0[9], l1[9], l2[9];
        const int c0 = bh * 64;
        if (lt < 64) *(LAS float*)(lds + SC_EG + lt * 4) = EGL[c0 + lt];
        load_chunk(c0, l0); store_chunk(0, l0);
        load_chunk(c0 + 1, l0); load_chunk(c0 + 2, l1); load_chunk(c0 + 3, l2);
        SC_BARRIER();
#define SC_LSTEP(nn, L) do { if ((nn) + 1 < 64) store_chunk(((nn) + 1) & 1, L); if ((nn) + 4 < 64) load_chunk(c0 + (nn) + 4, L); SC_BARRIER(); } while (0)
        for (int n = 0; n < 63; n += 3) { SC_LSTEP(n, l0); SC_LSTEP(n + 1, l1); SC_LSTEP(n + 2, l2); }
        SC_LSTEP(63, l0);
#undef SC_LSTEP
        return;
    }
    SC_BARRIER();
    const int fr = lane & 15, fq = lane >> 4;
    f32x4 S[8];
#pragma unroll
    for (int t = 0; t < 8; ++t) S[t] = (f32x4){0.f, 0.f, 0.f, 0.f};
    for (int n = 0; n < 64; ++n) {
        const int ci = bh * 64 + n;
        {
            LAS const unsigned char* L = lds + (n & 1) * SC_BUF;
            LAS const unsigned char* wp = L + SC_W + fr * 272 + fq * 16;
            LAS const unsigned char* qp = L + SC_QG + fr * 272 + fq * 16;
            LAS const unsigned char* ap = L + SC_A + fr * 144 + fq * 16;
            LAS const unsigned char* kp = L + SC_KGT + fr * 144 + fq * 16;
            const float eg = *(LAS const float*)(lds + SC_EG + n * 4);
            u32x4 un[2]; un[0] = *(LAS const u32x4*)(L + SC_U + lane * 32); un[1] = *(LAS const u32x4*)(L + SC_U + lane * 32 + 16);
            bf16x8 sb[4];
#pragma unroll
            for (int kt = 0; kt < 4; ++kt) { u32x4 pk; pk[0] = pk2(S[2 * kt][0], S[2 * kt][1]); pk[1] = pk2(S[2 * kt][2], S[2 * kt][3]); pk[2] = pk2(S[2 * kt + 1][0], S[2 * kt + 1][1]); pk[3] = pk2(S[2 * kt + 1][2], S[2 * kt + 1][3]); sb[kt] = __builtin_bit_cast(bf16x8, pk); }
            f32x4 vn[4], ot[4];
#pragma unroll
            for (int t = 0; t < 4; ++t) { vn[t] = (f32x4){0.f, 0.f, 0.f, 0.f}; ot[t] = (f32x4){0.f, 0.f, 0.f, 0.f}; }
            bf16x8 vb[2];
            bf16x8 fr12[12];
#define SC_FRAG(i) ((i) < 16 ? lds8(wp + ((i) >> 2) * 16 * 272 + ((i) & 3) * 64) \
                  : (i) < 32 ? lds8(qp + (((i) - 16) >> 2) * 16 * 272 + (((i) - 16) & 3) * 64) \
                  : (i) < 40 ? lds8(ap + (((i) - 32) >> 1) * 16 * 144 + (((i) - 32) & 1) * 64) \
                  :            lds8(kp + (((i) - 40) >> 1) * 16 * 144 + (((i) - 40) & 1) * 64))
#pragma unroll
            for (int i = 0; i < 8; ++i) fr12[i] = SC_FRAG(i);
            __builtin_amdgcn_sched_barrier(0);
#pragma unroll
            for (int g = 0; g < 14; ++g) {
                if (g + 2 < 14) {
#pragma unroll
                    for (int j = 0; j < 4; ++j) fr12[((g + 2) % 3) * 4 + j] = SC_FRAG(4 * (g + 2) + j);
                }
#pragma unroll
                for (int j = 0; j < 4; ++j) {
                    const int i = 4 * g + j; const bf16x8 f = fr12[(g % 3) * 4 + j];
                    if (i < 16) vn[i >> 2] = MFMA16(f, sb[i & 3], vn[i >> 2]);
                    else if (i < 32) ot[(i - 16) >> 2] = MFMA16(f, sb[(i - 16) & 3], ot[(i - 16) >> 2]);
                    else if (i < 40) ot[(i - 32) >> 1] = MFMA16(f, vb[(i - 32) & 1], ot[(i - 32) >> 1]);
                    else S[(i - 40) >> 1] = MFMA16(f, vb[(i - 40) & 1], S[(i - 40) >> 1]);
                }
                if (g == 1 || g == 3) {
                    const int ks = g >> 1; const u32x4 uu = un[ks];
                    f32x4 va, vbb;
                    va[0] = bflo(uu[0]) - vn[2 * ks][0]; va[1] = bfhi(uu[0]) - vn[2 * ks][1]; va[2] = bflo(uu[1]) - vn[2 * ks][2]; va[3] = bfhi(uu[1]) - vn[2 * ks][3];
                    vbb[0] = bflo(uu[2]) - vn[2 * ks + 1][0]; vbb[1] = bfhi(uu[2]) - vn[2 * ks + 1][1]; vbb[2] = bflo(uu[3]) - vn[2 * ks + 1][2]; vbb[3] = bfhi(uu[3]) - vn[2 * ks + 1][3];
                    u32x4 pk; pk[0] = pk2(va[0], va[1]); pk[1] = pk2(va[2], va[3]); pk[2] = pk2(vbb[0], vbb[1]); pk[3] = pk2(vbb[2], vbb[3]);
                    vb[ks] = __builtin_bit_cast(bf16x8, pk);
                }
                if (g >= 4 && g < 8) { S[2 * (g - 4)] *= eg; S[2 * (g - 4) + 1] *= eg; }
                __builtin_amdgcn_sched_barrier(0);
            }
#undef SC_FRAG
            float* op = OC + ((size_t)b * SEQ_ + n * 64 + 4 * fq) * 512 + h * 128 + slice * 16 + fr;
#pragma unroll
            for (int t = 0; t < 4; ++t)
#pragma unroll
                for (int rg = 0; rg < 4; ++rg) op[(size_t)(16 * t + rg) * 512] = ot[t][rg];
        }
        SC_BARRIER();
    }
#undef SC_BARRIER
}

__device__ __forceinline__ void phase_dnout(ArgsRef a, const Tb tb, int l) {
    unsigned char* ws = a.ws;
    const float* OC = (const float*)(ws + OFF_OCRAW); const bf16_t* Z = (const bf16_t*)(ws + OFF_Z); bf16_t* O = (bf16_t*)(ws + OFF_O);
    const float* g = a.in[11] + l * 128;
    const int wv = tb.tid >> 6, lane = tb.tid & 63, sub = lane >> 4, l16 = lane & 15;
    const int gw = tb.bid * 8 + wv, GW = tb.G * 8;
    const f32x4 g0 = *(const f32x4*)(g + l16 * 8), g1 = *(const f32x4*)(g + l16 * 8 + 4);
    for (int u = gw * 4 + sub; u < T_ * 4; u += GW * 4) {
        const int t = u >> 2, h = u & 3;
        const float* op = OC + (size_t)t * 512 + h * 128 + l16 * 8;
        const f32x4 v0 = *(const f32x4*)op, v1 = *(const f32x4*)(op + 4);
        const u32x4 zz = *(const u32x4*)(Z + (size_t)t * 512 + h * 128 + l16 * 8);
        float ss = (v0[0] * v0[0] + v0[1] * v0[1]) + (v0[2] * v0[2] + v0[3] * v0[3]) + (v1[0] * v1[0] + v1[1] * v1[1]) + (v1[2] * v1[2] + v1[3] * v1[3]);
        ss += __shfl_xor(ss, 8); ss += __shfl_xor(ss, 4); ss += __shfl_xor(ss, 2); ss += __shfl_xor(ss, 1);
        const float rn = rsqrtf(ss * (1.f / 128.f) + RMS_EPS_);
        float o[8];
#pragma unroll
        for (int i = 0; i < 4; ++i) {
            const float za = bflo(zz[i]), zb = bfhi(zz[i]);
            const float va = i < 2 ? v0[2 * i] : v1[2 * i - 4], vb = i < 2 ? v0[2 * i + 1] : v1[2 * i - 3];
            const float ga = i < 2 ? g0[2 * i] : g1[2 * i - 4], gb = i < 2 ? g0[2 * i + 1] : g1[2 * i - 3];
            o[2 * i] = va * rn * ga * (za * __builtin_amdgcn_rcpf(1.f + __expf(-za)));
            o[2 * i + 1] = vb * rn * gb * (zb * __builtin_amdgcn_rcpf(1.f + __expf(-zb)));
        }
        u32x4 w; w[0] = pk2(o[0], o[1]); w[1] = pk2(o[2], o[3]); w[2] = pk2(o[4], o[5]); w[3] = pk2(o[6], o[7]);
        *(u32x4*)(O + (size_t)t * 1024 + 512 + h * 128 + l16 * 8) = w;
    }
}

__device__ __forceinline__ void phase_final(ArgsRef a, const Tb tb) {
    const float* part = (const float*)(a.ws + OFF_STATS) + (size_t)5 * T_ * 32;
    const float* g = a.in[5] + 5 * D_; const float* bb = a.in[6] + 5 * D_;
    const int wv = tb.tid >> 6, lane = tb.tid & 63;
    const int gw = tb.bid * 8 + wv, GW = tb.G * 8;
    for (int t = gw; t < T_; t += GW) {
        float s = 0.f, q = 0.f;
        if (lane < 8) { const f32x4 v = *(const f32x4*)(part + (size_t)t * 32 + lane * 4); s = v[0] + v[2]; q = v[1] + v[3]; }
        s = wave_sum(s); q = wave_sum(q);
        const float mu = s * (1.f / 1024.f), rstd = rsqrtf(fmaxf(q * (1.f / 1024.f) - mu * mu, 0.f) + LN_EPS_);
#pragma unroll
        for (int i = 0; i < 4; ++i) {
            const int col = i * 256 + lane * 4;
            const u32x2 rb = *(const u32x2*)((const bf16_t*)(a.ws + OFF_YB) + (size_t)t * D_ + col);
            f32x4 y = (f32x4){bflo(rb.x), bfhi(rb.x), bflo(rb.y), bfhi(rb.y)};
            const f32x4 g4 = *(const f32x4*)(g + col), b4 = *(const f32x4*)(bb + col);
            y = (y - mu) * rstd * g4 + b4;
            __builtin_nontemporal_store(y, (f32x4*)(a.out + (size_t)t * D_ + col));
        }
    }
}

#define XB_TMO      128
#define XB_XCNT(j)  (256  + 64 * (j))
#define XB_XSUB(j)  (1280 + 64 * (j))
#define XB_XGEN(j)  (2304 + 64 * (j))
#define XB_TOP      3328
#define XB_TOPGEN   3392
#define XCD_BAR_WORDS 3456
#define XB_SPIN_CAP (1u << 18)

__device__ __forceinline__ unsigned xb_ld(unsigned* p)              { return __hip_atomic_load(p, __ATOMIC_RELAXED, __HIP_MEMORY_SCOPE_AGENT); }
__device__ __forceinline__ unsigned xb_add(unsigned* p, unsigned v) { return __hip_atomic_fetch_add(p, v, __ATOMIC_RELAXED, __HIP_MEMORY_SCOPE_AGENT); }
__device__ __forceinline__ unsigned xb_xcc_id() { return (unsigned)__builtin_amdgcn_s_getreg((3 << 11) | 20) & 0xFu; }
#define XB_SPIN(cond, bar) do { unsigned _sp = 0; while (cond) { __builtin_amdgcn_s_sleep(1); \
    if ((++_sp & 255u) == 0u) { if (xb_ld(&(bar)[XB_TMO])) break; if (_sp > XB_SPIN_CAP) { atomicAdd(&(bar)[XB_TMO], 1u); break; } } } } while (0)

struct XcdBarrier {
    unsigned* bar; unsigned x;
    volatile LAS unsigned* st;
};

__device__ __forceinline__ XcdBarrier xcd_barrier_post(unsigned* bar, volatile LAS unsigned* st) {
    XcdBarrier b; b.bar = bar; b.x = xb_xcc_id(); b.st = st;
    if (threadIdx.x == 0) (void)xb_add(&bar[XB_XCNT(b.x)], 1u);
    return b;
}
__device__ __forceinline__ void xcd_barrier_complete(unsigned* bar, unsigned x, unsigned& nloc, unsigned& nx) {
    const unsigned G = gridDim.x * gridDim.y * gridDim.z;
    unsigned sum, cnt, mine, sp = 0u;
    for (;;) {
        sum = 0u; cnt = 0u; mine = 0u;
#pragma unroll
        for (unsigned j = 0; j < 16; ++j) { const unsigned c = xb_ld(&bar[XB_XCNT(j)]); sum += c; cnt += (c > 0u) ? 1u : 0u; mine = (j == x) ? c : mine; }
        if (sum == G) break;
        __builtin_amdgcn_s_sleep(1);
        if ((++sp & 255u) == 0u) { if (xb_ld(&bar[XB_TMO])) break; if (sp > XB_SPIN_CAP) { atomicAdd(&bar[XB_TMO], 1u); break; } }
    }
    nloc = mine > 0u ? mine : 1u; nx = cnt > 0u ? cnt : 1u;
}

__device__ __forceinline__ void xcd_barrier(const XcdBarrier& b) {
    asm volatile("s_waitcnt vmcnt(0)" ::: "memory");
    __syncthreads();
    if (threadIdx.x == 0) {
        unsigned* bar = b.bar;
        __builtin_amdgcn_s_waitcnt(0);
        unsigned nloc = b.st[0], nx = b.st[1];
        if (nloc == 0u) { xcd_barrier_complete(bar, b.x, nloc, nx); b.st[0] = nloc; b.st[1] = nx; }
        const unsigned old = xb_add(&bar[XB_XSUB(b.x)], 1u);
        const unsigned gen = old / nloc;
        if (old + 1u == (gen + 1u) * nloc) {
            __builtin_amdgcn_fence(__ATOMIC_RELEASE, "agent");
            asm volatile("s_waitcnt vmcnt(0)" ::: "memory");
            const unsigned og = xb_add(&bar[XB_TOP], 1u);
            const unsigned tg = og / nx;
            if (og + 1u == (tg + 1u) * nx) xb_add(&bar[XB_TOPGEN], 1u);
            else XB_SPIN(xb_ld(&bar[XB_TOPGEN]) == tg, bar);
            __builtin_amdgcn_fence(__ATOMIC_ACQUIRE, "agent");
            xb_add(&bar[XB_XGEN(b.x)], 1u);
            asm volatile("s_waitcnt vmcnt(0)" ::: "memory");
        } else {
            XB_SPIN(xb_ld(&bar[XB_XGEN(b.x)]) == gen, bar);
            __builtin_amdgcn_fence(__ATOMIC_ACQUIRE, "agent");
            asm volatile("s_waitcnt vmcnt(0)" ::: "memory");
        }
    }
    __syncthreads();
}


#ifdef ONLY
#define PH_ENABLED(n) ((n) == ONLY)
#else
#define PH_ENABLED(n) true
#endif
constexpr int PH_PER_LAYER = 14, N_PHASES = 2 * PH_PER_LAYER + 1;
__device__ __forceinline__ void run_phase(int ph, LAS unsigned char* lds) {
    const __attribute__((address_space(4))) Args* ap = (const __attribute__((address_space(4))) Args*)__builtin_amdgcn_kernarg_segment_ptr();
    asm volatile("" : "+s"(ap));
    ArgsRef a = *ap;
    Tb tb; tb.tid = threadIdx.x; tb.bid = blockIdx.x; tb.G = gridDim.x;
    asm volatile("" : "+v"(tb.tid)); asm volatile("" : "+s"(tb.bid)); asm volatile("" : "+s"(tb.G));
    unsigned char* ws = a.ws;
    if (ph == N_PHASES - 1) { if (PH_ENABLED(99)) phase_final(a, tb); return; }
    const int l = ph / PH_PER_LAYER, p = ph % PH_PER_LAYER;
    float* stats = (float*)(ws + OFF_STATS);
    const float* mur = (const float*)(ws + OFF_MUR);
    const float* mu_in = l > 0 ? mur + (size_t)((l - 1) * 3 + 2) * T_ * 2 : nullptr;
    const float* mu0 = mur + (size_t)(l * 3 + 0) * T_ * 2; const float* mu1 = mur + (size_t)(l * 3 + 1) * T_ * 2;
    float* st0 = stats + (size_t)(l * 3 + 0) * T_ * 32; float* st1 = stats + (size_t)(l * 3 + 1) * T_ * 32; float* st2 = stats + (size_t)(l * 3 + 2) * T_ * 32;
    const float* ln_g = a.in[5]; const float* ln_b = a.in[6];
    pg8::StaticOrder S;
    switch (p) {
    case 0: if (PH_ENABLED(0)) { if (l == 0) pro_part(a, tb, 0, 0, tb.bid, tb.G, lds); } break;
    case 1: if (PH_ENABLED(1)) { pg8::Gemm g{(const bf16_t*)(ws + OFF_YB), (const bf16_t*)(ws + OFF_WGU0), T_, 2 * FF_, D_}; S.init(g.M, g.N, tb.G, tb.bid);
        EpiGU E{(bf16_t*)(ws + OFF_H), mu_in, (const float*)(ws + OFF_C12GU0), (const float*)(ws + OFF_C12GU0) + 5632}; pg8::gemm_phase(tb, lds, g, S, E); } break;
    case 2: if (PH_ENABLED(2)) { pg8::Gemm g{(const bf16_t*)(ws + OFF_H), (const bf16_t*)(ws + OFF_WDN0), T_, D_, FF_}; S.init(g.M, g.N, tb.G, tb.bid);
        EpiRes E{nullptr, (bf16_t*)(ws + OFF_YB), mu_in, l > 0 ? ln_g + ((l - 1) * 3 + 2) * D_ : nullptr, l > 0 ? ln_b + ((l - 1) * 3 + 2) * D_ : nullptr, st0, 0.5f}; pg8::gemm_phase(tb, lds, g, S, E); } break;
    case 3: if (PH_ENABLED(3)) phase_statsfin(a, tb, l * 3 + 0); break;
    case 4: if (PH_ENABLED(4)) { pg8::Gemm g{(const bf16_t*)(ws + OFF_YB), (const bf16_t*)(ws + OFF_WIN), T_, NING_, D_}; S.init(g.M, g.N, tb.G, tb.bid);
        EpiIn E{mu0, (const float*)(ws + OFF_C12IN), (const float*)(ws + OFF_C12IN) + 3584, (bf16_t*)(ws + OFF_QK), (bf16_t*)(ws + OFF_VT), (bf16_t*)(ws + OFF_PC), (bf16_t*)(ws + OFF_Z)}; pg8::gemm_phase(tb, lds, g, S, E);
        } break;
    case 5: if (PH_ENABLED(5)) { phase_gates(a, tb, l); phase_attn(a, tb, l, lds); } break;
    case 6: if (PH_ENABLED(6)) phase_dnprep(a, tb, l, lds); break;
    case 7: if (PH_ENABLED(7)) { phase_dnscan(a, tb, lds);
        if (tb.bid >= 128) { pro_part(a, tb, l, 1, tb.bid - 128, tb.G - 128, lds); if (l == 0) pro_part(a, tb, 1, 0, tb.bid - 128, tb.G - 128, lds); } } break;
    case 8: if (PH_ENABLED(8)) phase_dnout(a, tb, l); break;
    case 9: if (PH_ENABLED(9)) { pg8::Gemm g{(const bf16_t*)(ws + OFF_O), (const bf16_t*)(ws + OFF_WOUT), T_, D_, D_}; S.init(g.M, g.N, tb.G, tb.bid);
        EpiRes E{nullptr, (bf16_t*)(ws + OFF_YB), mu0, ln_g + (l * 3 + 0) * D_, ln_b + (l * 3 + 0) * D_, st1, 1.0f}; pg8::gemm_phase(tb, lds, g, S, E); } break;
    case 10: if (PH_ENABLED(10)) phase_statsfin(a, tb, l * 3 + 1); break;
    case 11: if (PH_ENABLED(11)) { pg8::Gemm g{(const bf16_t*)(ws + OFF_YB), (const bf16_t*)(ws + OFF_WGU1), T_, 2 * FF_, D_}; S.init(g.M, g.N, tb.G, tb.bid);
        EpiGU E{(bf16_t*)(ws + OFF_H), mu1, (const float*)(ws + OFF_C12GU1), (const float*)(ws + OFF_C12GU1) + 5632}; pg8::gemm_phase(tb, lds, g, S, E); } break;
    case 12: if (PH_ENABLED(12)) { pg8::Gemm g{(const bf16_t*)(ws + OFF_H), (const bf16_t*)(ws + OFF_WDN1), T_, D_, FF_}; S.init(g.M, g.N, tb.G, tb.bid);
        EpiRes E{nullptr, (bf16_t*)(ws + OFF_YB), mu1, ln_g + (l * 3 + 1) * D_, ln_b + (l * 3 + 1) * D_, st2, 0.5f}; pg8::gemm_phase(tb, lds, g, S, E); } break;
    case 13: if (PH_ENABLED(13)) phase_statsfin(a, tb, l * 3 + 2); break;
    }
}

__global__ void __launch_bounds__(512, 2) mk_fwd(Args a) {
    extern __shared__ __attribute__((aligned(16))) unsigned char shm[];
    LAS unsigned char* lds = (LAS unsigned char*)shm;
#if MULTI_LAUNCH
    run_phase(a.ph_lo, lds);
#else
    cg::grid_group grid = cg::this_grid();
    volatile LAS unsigned* st = (volatile LAS unsigned*)(lds + 131072);
    if (threadIdx.x == 0) { st[0] = 0u; st[1] = 0u; }
    __syncthreads();
    const XcdBarrier xb = xcd_barrier_post((unsigned*)(a.ws + OFF_BAR), st);
    if (a.ph_hi < 0) grid.sync();
    for (int ph = a.ph_lo; ph < a.ph_hi; ++ph) {
        if (ph == PH_PER_LAYER || ph == 2 * PH_PER_LAYER - 1) continue;
        run_phase(ph, lds);
        if (ph + 1 < a.ph_hi) xcd_barrier(xb);
    }
#endif
}

extern "C" void kernel_launch(void* const* d_in, const int* in_sizes, int n_in, void* d_out, int out_size, void* d_ws, size_t ws_size, hipStream_t stream) {
    static int grid = 0;
    if (grid == 0) {
        if (n_in != 16 || out_size != T_ * D_ || ws_size < WS_END) { fprintf(stderr, "kernel_launch: unexpected shapes (n_in %d out %d ws %zu need %zu)\n", n_in, out_size, ws_size, (size_t)WS_END); grid = -1; return; }
        int dev = 0, cus = 0, per_cu = 0;
        hipGetDevice(&dev);
        hipDeviceGetAttribute(&cus, hipDeviceAttributeMultiprocessorCount, dev);
        if (hipFuncSetAttribute((const void*)mk_fwd, hipFuncAttributeMaxDynamicSharedMemorySize, LDS_BYTES) != hipSuccess) { fprintf(stderr, "kernel_launch: hipFuncSetAttribute failed\n"); grid = -1; return; }
        hipOccupancyMaxActiveBlocksPerMultiprocessor(&per_cu, (const void*)mk_fwd, 512, LDS_BYTES);
        (void)hipGetLastError();
        if (per_cu < 1) per_cu = 1;
        grid = cus * 1;
        fprintf(stderr, "kernel_launch: cus %d per_cu %d grid %d\n", cus, per_cu, grid);
    }
    if (grid < 0) return;
    Args a{};
    for (int i = 0; i < 16; ++i) a.in[i] = (const float*)d_in[i];
    a.out = (float*)d_out; a.ws = (unsigned char*)d_ws;
#if MULTI_LAUNCH
    for (int ph = 0; ph < N_PHASES; ++ph) {
        a.ph_lo = ph; a.ph_hi = ph + 1;
        hipLaunchKernelGGL(mk_fwd, dim3(grid), dim3(512), LDS_BYTES, stream, a);
    }
#else
    a.ph_lo = 0; a.ph_hi = N_PHASES;
    if (hipMemsetAsync((unsigned char*)d_ws + OFF_BAR, 0, BAR_BYTES, stream) != hipSuccess) { fprintf(stderr, "kernel_launch: memset of the barrier words failed\n"); return; }
    void* args[] = {&a};
    hipError_t e = hipLaunchCooperativeKernel((const void*)mk_fwd, dim3(grid), dim3(512), args, LDS_BYTES, stream);
    if (e != hipSuccess) fprintf(stderr, "cooperative launch failed: %s (grid %d)\n", hipGetErrorString(e), grid);
#endif
}
```
